# Optimizing an MI355X kernel written in HIP

```python
import jax, jax.numpy as jnp
from jax import lax
import numpy as np

D_MODEL = 2048
BATCH = 1
SEQ = 8192
DEPTH = 2

N_META = 16
Q_BLOCK = 128
MLA_HEADS = 8
MLA_Q_LORA = 512
MLA_KV_LORA = 512
MLA_NOPE_DIM = 128
MLA_ROPE_DIM = 64
MLA_V_DIM = 128
ROPE_THETA = 10000.0
FOX_HEADS = 8
FOX_HEAD_DIM = 128
_ATTN_SIZES = (MLA_Q_LORA, MLA_KV_LORA, MLA_ROPE_DIM,
               FOX_HEADS * FOX_HEAD_DIM, FOX_HEADS * FOX_HEAD_DIM, FOX_HEADS * FOX_HEAD_DIM,
               FOX_HEADS)
ATTN_IN = int(sum(_ATTN_SIZES))
ATTN_SPLITS = tuple(int(v) for v in np.cumsum(_ATTN_SIZES)[:-1])
ATTN_OUT = MLA_HEADS * MLA_V_DIM + FOX_HEADS * FOX_HEAD_DIM
POOL_WINDOWS = (2, 4, 8, 16)
POOL_WIDTH = D_MODEL
POOL_GROUP = POOL_WIDTH // len(POOL_WINDOWS)
FFN_DENSE = 5632
N_EXPERTS = 8
TOP_K = 2
FFN_EXPERT = 7168
MOE_BLOCK = 128
ALPHA = (2 * DEPTH) ** 0.25
BETA = (8 * DEPTH) ** -0.25
LN_EPS = 1e-5
RMS_EPS = 1e-6
NEG_INF = -1e30
N_EVEN = (DEPTH + 1) // 2
N_ODD = DEPTH // 2

kernel_name = "hybrid_mla_fox_pool_moe_deepnorm"


def layer_norm(x, g, b):
    xf = x.astype(jnp.float32)
    mu = jnp.mean(xf, axis=-1, keepdims=True)
    var = jnp.mean(jnp.square(xf - mu), axis=-1, keepdims=True)
    return ((xf - mu) * lax.rsqrt(var + LN_EPS) * g + b).astype(x.dtype)


def rms_norm(x, g):
    xf = x.astype(jnp.float32)
    return (xf * lax.rsqrt(jnp.mean(jnp.square(xf), axis=-1, keepdims=True) + RMS_EPS) * g).astype(x.dtype)


def rope(x, cos, sin):
    x1, x2 = jnp.split(x, 2, axis=-1)
    return jnp.concatenate([x1 * cos - x2 * sin, x2 * cos + x1 * sin], axis=-1)


def causal_block_attention(q, k, v, scale, log_decay_cum=None):
    B, H, L, dk = q.shape
    dv = v.shape[-1]
    lead = (-N_META) % Q_BLOCK
    lq = lead + L
    nb = -(-lq // Q_BLOCK)
    tail = nb * Q_BLOCK - lq
    qp = jnp.pad(q, ((0, 0), (0, 0), (lead, tail), (0, 0)))
    q_blocks = qp.reshape(B, H, nb, Q_BLOCK, dk).transpose(2, 0, 1, 3, 4)
    q_pos = (jnp.arange(nb * Q_BLOCK) - lead).reshape(nb, Q_BLOCK)
    k_pos = jnp.arange(L)
    xs = (q_blocks, q_pos)
    if log_decay_cum is not None:
        cp = jnp.pad(log_decay_cum, ((0, 0), (0, 0), (lead, tail)))
        xs = xs + (cp.reshape(B, H, nb, Q_BLOCK).transpose(2, 0, 1, 3),)
        k_is_meta = (k_pos < N_META)[None, None, None, :]

    def one_block(blk):
        qb, pos = blk[0], blk[1]
        s = jnp.einsum('bhtd,bhsd->bhts', qb, k).astype(jnp.float32) * scale
        if log_decay_cum is not None:
            decay = blk[2][..., :, None] - log_decay_cum[:, :, None, :]
            s = s + jnp.where(k_is_meta, 0.0, decay)
        mask = k_pos[None, :] <= pos[:, None]
        s = jnp.where(mask, s, NEG_INF)
        p = jax.nn.softmax(s, axis=-1).astype(v.dtype)
        return jnp.einsum('bhts,bhsd->bhtd', p, v)

    o = lax.map(one_block, xs)
    o = o.transpose(1, 2, 0, 3, 4).reshape(B, H, nb * Q_BLOCK, dv)
    return o[:, :, lead:lead + L]


def mla_fox_mixer(x, w_in, fox_b_f, q_norm, kv_norm, w_uq, w_ukv, w_out, cos, sin):
    B, L, _ = x.shape
    h = x @ w_in
    c_q, c_kv, k_r, q_f, k_f, v_f, f_logit = jnp.split(h, ATTN_SPLITS, axis=-1)
    q = (rms_norm(c_q, q_norm) @ w_uq).reshape(B, L, MLA_HEADS, MLA_NOPE_DIM + MLA_ROPE_DIM)
    q_nope, q_rot = q[..., :MLA_NOPE_DIM], q[..., MLA_NOPE_DIM:]
    q_rot = rope(q_rot, cos[:, None, :], sin[:, None, :])
    kv = (rms_norm(c_kv, kv_norm) @ w_ukv).reshape(B, L, MLA_HEADS, MLA_NOPE_DIM + MLA_V_DIM)
    k_nope, v_m = kv[..., :MLA_NOPE_DIM], kv[..., MLA_NOPE_DIM:]
    k_rot = rope(k_r, cos, sin)
    k_rot = jnp.broadcast_to(k_rot[:, :, None, :], (B, L, MLA_HEADS, MLA_ROPE_DIM))
    q_m = jnp.concatenate([q_nope, q_rot], axis=-1).transpose(0, 2, 1, 3)
    k_m = jnp.concatenate([k_nope, k_rot], axis=-1).transpose(0, 2, 1, 3)
    o_mla = causal_block_attention(q_m, k_m, v_m.transpose(0, 2, 1, 3),
                                   (MLA_NOPE_DIM + MLA_ROPE_DIM) ** -0.5)
    to_heads = lambda t: t.reshape(B, L, FOX_HEADS, FOX_HEAD_DIM).transpose(0, 2, 1, 3)
    log_f = jax.nn.log_sigmoid(f_logit.astype(jnp.float32) + fox_b_f)
    cum = jnp.cumsum(log_f, axis=1).transpose(0, 2, 1)
    o_fox = causal_block_attention(to_heads(q_f), to_heads(k_f), to_heads(v_f),
                                   FOX_HEAD_DIM ** -0.5, cum)
    o = jnp.concatenate([o_mla, o_fox], axis=1).transpose(0, 2, 1, 3).reshape(B, L, ATTN_OUT)
    return o @ w_out


def pool_mixer(x, w_in, w_group, scale, w_out):
    B, L, _ = x.shape
    h = (x @ w_in).reshape(B, L, len(POOL_WINDOWS), POOL_GROUP)
    count = jnp.arange(1, L + 1, dtype=jnp.float32)
    outs = []
    for g, w in enumerate(POOL_WINDOWS):
        hg = h[:, :, g].astype(jnp.float32)
        cs = jnp.cumsum(hg, axis=1)
        lower = jnp.pad(cs[:, :L - w], ((0, 0), (w, 0), (0, 0)))
        mean = (cs - lower) / jnp.minimum(count, float(w))[None, :, None]
        outs.append((mean - hg).astype(x.dtype) @ w_group[g])
    y = jnp.concatenate(outs, axis=-1) * scale
    return y @ w_out


def swiglu(x, w_gate, w_up, w_down):
    return (jax.nn.silu(x @ w_gate) * (x @ w_up)) @ w_down


def moe_swiglu(x, w_router, b_router, w_gate, w_up, w_down):
    B, L, D = x.shape
    n = B * L
    xt = x.reshape(n, D)
    logits = (xt @ w_router).astype(jnp.float32) + b_router
    top_val, top_idx = lax.top_k(logits, TOP_K)
    gates = jax.nn.softmax(top_val, axis=-1)
    a = n * TOP_K
    expert_of = top_idx.reshape(a)
    token_of = jnp.arange(a, dtype=jnp.int32) // TOP_K
    gate_of = gates.reshape(a)
    order = jnp.argsort(expert_of)
    e_sorted = expert_of[order]
    counts = jnp.bincount(expert_of, length=N_EXPERTS)
    padded = (counts + MOE_BLOCK - 1) // MOE_BLOCK * MOE_BLOCK
    seg_end = jnp.cumsum(padded)
    seg_start = seg_end - padded
    first = jnp.cumsum(counts) - counts
    dest = seg_start[e_sorted] + jnp.arange(a) - first[e_sorted]
    n_blocks = -(-a // MOE_BLOCK) + N_EXPERTS
    cap = n_blocks * MOE_BLOCK
    row_token = jnp.full((cap,), n, jnp.int32).at[dest].set(token_of[order])
    row_gate = jnp.zeros((cap,), jnp.float32).at[dest].set(gate_of[order])
    block_expert = jnp.minimum(
        jnp.searchsorted(seg_end, jnp.arange(n_blocks) * MOE_BLOCK, side='right'), N_EXPERTS - 1)
    x_rows = jnp.concatenate([xt, jnp.zeros((1, D), xt.dtype)], axis=0)[row_token]
    x_rows = x_rows.reshape(n_blocks, MOE_BLOCK, D)

    def expert_block(args):
        xb, e = args
        return (jax.nn.silu(xb @ w_gate[e]) * (xb @ w_up[e])) @ w_down[e]

    y_rows = lax.map(expert_block, (x_rows, block_expert)).reshape(cap, D)
    y = jax.ops.segment_sum(y_rows.astype(jnp.float32) * row_gate[:, None], row_token,
                            num_segments=n + 1)[:n]
    return y.astype(x.dtype).reshape(B, L, D)


def setup_inputs(seed: int = 0) -> dict:
    key = jax.random.key(seed)
    ks = iter(jax.random.split(key, 32))

    def nrm(shape, scale):
        return jax.random.normal(next(ks), shape, jnp.float32) * scale

    D = D_MODEL
    return {
        "x": nrm((BATCH, SEQ, D), 1.0),
        "meta_tokens": nrm((N_META, D), 1.0),
        "attn_w_in": nrm((N_EVEN, D, ATTN_IN), D ** -0.5),
        "fox_forget_bias": 3.0 + nrm((N_EVEN, FOX_HEADS), 0.5),
        "mla_q_norm": 1.0 + nrm((N_EVEN, MLA_Q_LORA), 0.1),
        "mla_kv_norm": 1.0 + nrm((N_EVEN, MLA_KV_LORA), 0.1),
        "mla_w_uq": nrm((N_EVEN, MLA_Q_LORA, MLA_HEADS * (MLA_NOPE_DIM + MLA_ROPE_DIM)), MLA_Q_LORA ** -0.5),
        "mla_w_ukv": nrm((N_EVEN, MLA_KV_LORA, MLA_HEADS * (MLA_NOPE_DIM + MLA_V_DIM)), MLA_KV_LORA ** -0.5),
        "attn_w_out": nrm((N_EVEN, ATTN_OUT, D), BETA * ATTN_OUT ** -0.5),
        "pool_w_in": nrm((N_ODD, D, POOL_WIDTH), D ** -0.5),
        "pool_w_group": nrm((N_ODD, len(POOL_WINDOWS), POOL_GROUP, POOL_GROUP), POOL_GROUP ** -0.5),
        "pool_scale": 1.0 + nrm((N_ODD, POOL_WIDTH), 0.1),
        "pool_w_out": nrm((N_ODD, POOL_WIDTH, D), BETA * POOL_WIDTH ** -0.5),
        "ffn_w_gate": nrm((N_EVEN, D, FFN_DENSE), D ** -0.5),
        "ffn_w_up": nrm((N_EVEN, D, FFN_DENSE), D ** -0.5),
        "ffn_w_down": nrm((N_EVEN, FFN_DENSE, D), BETA * FFN_DENSE ** -0.5),
        "moe_w_router": nrm((N_ODD, D, N_EXPERTS), D ** -0.5),
        "moe_b_router": nrm((N_ODD, N_EXPERTS), 0.01),
        "moe_w_gate": nrm((N_ODD, N_EXPERTS, D, FFN_EXPERT), D ** -0.5),
        "moe_w_up": nrm((N_ODD, N_EXPERTS, D, FFN_EXPERT), D ** -0.5),
        "moe_w_down": nrm((N_ODD, N_EXPERTS, FFN_EXPERT, D), BETA * FFN_EXPERT ** -0.5),
        "ln_mix_g": 1.0 + nrm((DEPTH, D), 0.1),
        "ln_mix_b": nrm((DEPTH, D), 0.02),
        "ln_ffn_g": 1.0 + nrm((DEPTH, D), 0.1),
        "ln_ffn_b": nrm((DEPTH, D), 0.02),
    }


def reference(x, meta_tokens, attn_w_in, fox_forget_bias, mla_q_norm, mla_kv_norm, mla_w_uq,
              mla_w_ukv, attn_w_out, pool_w_in, pool_w_group, pool_scale, pool_w_out,
              ffn_w_gate, ffn_w_up, ffn_w_down, moe_w_router, moe_b_router, moe_w_gate,
              moe_w_up, moe_w_down, ln_mix_g, ln_mix_b, ln_ffn_g, ln_ffn_b):
    B = x.shape[0]
    meta = jnp.broadcast_to(meta_tokens[None].astype(x.dtype), (B, N_META, D_MODEL))
    h = jnp.concatenate([meta, x], axis=1)
    L = h.shape[1]
    pos = jnp.arange(L, dtype=jnp.float32)
    inv_freq = ROPE_THETA ** (-jnp.arange(0, MLA_ROPE_DIM, 2, dtype=jnp.float32) / MLA_ROPE_DIM)
    ang = pos[:, None] * inv_freq[None, :]
    cos = jnp.cos(ang).astype(x.dtype)
    sin = jnp.sin(ang).astype(x.dtype)
    for i in range(DEPTH):
        j = i // 2
        if i % 2 == 0:
            m = mla_fox_mixer(h, attn_w_in[j], fox_forget_bias[j], mla_q_norm[j], mla_kv_norm[j],
                              mla_w_uq[j], mla_w_ukv[j], attn_w_out[j], cos, sin)
        else:
            m = pool_mixer(h, pool_w_in[j], pool_w_group[j], pool_scale[j], pool_w_out[j])
        h = layer_norm(ALPHA * h + m, ln_mix_g[i], ln_mix_b[i])
        if i % 2 == 0:
            f = swiglu(h, ffn_w_gate[j], ffn_w_up[j], ffn_w_down[j])
        else:
            f = moe_swiglu(h, moe_w_router[j], moe_b_router[j], moe_w_gate[j], moe_w_up[j], moe_w_down[j])
        h = layer_norm(ALPHA * h + f, ln_ffn_g[i], ln_ffn_b[i])
    return h[:, N_META:]
```

```cpp
#include <hip/hip_runtime.h>
#include <cstdio>
#include <cstdint>

#ifndef MK_ONE_LAUNCH
#define MK_ONE_LAUNCH 1
#endif
#ifndef DUP_MASK
#define DUP_MASK 0u
#endif
#ifndef NAIVE_ATTN
#define NAIVE_ATTN 0
#endif

#define GAS __attribute__((address_space(1)))
#define LAS __attribute__((address_space(3)))
typedef unsigned short bf16_t;
typedef short bf16x8 __attribute__((ext_vector_type(8)));
typedef float f32x4 __attribute__((ext_vector_type(4)));
typedef float f32x2 __attribute__((ext_vector_type(2)));
typedef unsigned u32x4 __attribute__((ext_vector_type(4)));
typedef unsigned u32x2 __attribute__((ext_vector_type(2)));

constexpr int DM = 2048, SEQ = 8192, NMETA = 16, LTOK = SEQ + NMETA;
constexpr int PADR = 240, ROW0 = 256, R = 8448, NPAN = 33;
constexpr int NH = 16, DKP = 192, DV = 128;
constexpr int NIN = 4352, NUP = 3584, FFN = 5632, NE = 8, FE = 7168, CAP = 8192, KS = 2;
constexpr float ALPHA = 1.41421356237309515f, LN_EPS = 1e-5f, RMS_EPS = 1e-6f;
constexpr float LOG2E = 1.4426950408889634f;
constexpr float QS_MLA = 0.07216878364870323f * LOG2E;
constexpr float SX8 = 16.f, SWGU8 = 512.f, SACT8 = 4.f, SWDN8 = 2048.f;
constexpr int FULL_TILES = 64, KSB = 7, OVF_ROWS = 2048;
constexpr float QS_FOX = 0.08838834764831845f * LOG2E;
__constant__ float INV_FREQ[32] = {1.000000000e+00f, 7.498942614e-01f, 5.623413324e-01f, 4.216965139e-01f, 3.162277639e-01f, 2.371373773e-01f, 1.778279394e-01f, 1.333521307e-01f,
    1.000000015e-01f, 7.498941571e-02f, 5.623413250e-02f, 4.216965288e-02f, 3.162277490e-02f, 2.371373773e-02f, 1.778279431e-02f, 1.333521493e-02f,
    9.999999776e-03f, 7.498941850e-03f, 5.623413250e-03f, 4.216964822e-03f, 3.162277630e-03f, 2.371373586e-03f, 1.778279431e-03f, 1.333521446e-03f,
    1.000000047e-03f, 7.498942432e-04f, 5.623413017e-04f, 4.216965172e-04f, 3.162277571e-04f, 2.371373703e-04f, 1.778279402e-04f, 1.333521504e-04f};

constexpr size_t MiB = 1u << 20;
constexpr size_t WS_CTL = 0, CTL_ZERO_BYTES = 65536;
constexpr size_t WS_CS = 1 * MiB;
constexpr size_t WS_SSQ = 3 * MiB + 256 * 1024;
constexpr size_t WS_SLOT = WS_SSQ;
constexpr size_t WS_C12 = 3 * MiB + 128 * 1024;
constexpr size_t WS_W_IN = 4 * MiB;
constexpr size_t WS_W_UP = 21 * MiB;
constexpr size_t WS_W_OUT = 25 * MiB;
constexpr size_t WS_W_GU = 33 * MiB;
constexpr size_t WS_W_DN = 77 * MiB;
constexpr size_t WS_W_PIN = 99 * MiB;
constexpr size_t WS_W_GRP = 107 * MiB;
constexpr size_t WS_W_POUT = 109 * MiB;
constexpr size_t WS_W_MGU = 117 * MiB;
constexpr size_t WS_W_MDN = 565 * MiB;
constexpr size_t WS_Y = 789 * MiB;
constexpr size_t WS_H3F = 855 * MiB;
constexpr size_t WS_RINFO = 921 * MiB;
constexpr size_t WS_TOKG = 921 * MiB + 512 * 1024;
constexpr size_t WS_OV = 922 * MiB;
constexpr size_t WS_L_CQKV = 922 * MiB;
constexpr size_t WS_L_KR = 939 * MiB;
constexpr size_t WS_L_LF = 941 * MiB + 512 * 1024;
constexpr size_t WS_L_QP = 942 * MiB;
constexpr size_t WS_L_KP = 992 * MiB;
constexpr size_t WS_L_VP = 1042 * MiB;
constexpr size_t WS_L_O = 1075 * MiB;
constexpr size_t WS_L_H1F = 1108 * MiB;
constexpr size_t WS_L_H1B = 1174 * MiB;
constexpr size_t WS_L_ACT = 1207 * MiB;
constexpr size_t WS_L_H2F = 1298 * MiB;
constexpr size_t WS_L_H2B = 1364 * MiB;
constexpr size_t WS_L_HP = 1397 * MiB;
constexpr size_t WS_L_PB = 1463 * MiB;
constexpr size_t WS_L_YP = 1496 * MiB;
constexpr size_t WS_L_H0B = 1529 * MiB;
constexpr size_t WS_END = 1562 * MiB;
constexpr size_t WS_M_XG = 922 * MiB;
constexpr size_t WS_M_ACT = 1178 * MiB;
constexpr int CW_TMO = 0, CW_CODE = 1, CW_BAR = 4096, CW_CNT = 8192;

constexpr int RING_BYTES = 151552;
constexpr int LDS_PSTAT = 131072;
constexpr int MISC_OFF = RING_BYTES;
constexpr int LDS_BYTES = 155648;

__device__ __forceinline__ unsigned cvt_pk_bf16(float lo, float hi) { unsigned r; asm volatile("v_cvt_pk_bf16_f32 %0, %1, %2" : "=v"(r) : "v"(lo), "v"(hi)); return r; }
__device__ __forceinline__ u32x4 pack8(f32x4 a, f32x4 b) { u32x4 w; w.x = cvt_pk_bf16(a[0], a[1]); w.y = cvt_pk_bf16(a[2], a[3]); w.z = cvt_pk_bf16(b[0], b[1]); w.w = cvt_pk_bf16(b[2], b[3]); return w; }
__device__ __forceinline__ u32x2 pack4(f32x4 a) { u32x2 w; w.x = cvt_pk_bf16(a[0], a[1]); w.y = cvt_pk_bf16(a[2], a[3]); return w; }
__device__ __forceinline__ float bf_lo(unsigned w) { return __uint_as_float(w << 16); }
__device__ __forceinline__ float bf_hi(unsigned w) { return __uint_as_float(w & 0xffff0000u); }
__device__ __forceinline__ float bf2f(bf16_t b) { return __uint_as_float(((unsigned)b) << 16); }
__device__ __forceinline__ bf16_t f2bf(float f) { return (bf16_t)(cvt_pk_bf16(f, 0.f) & 0xffffu); }
__device__ __forceinline__ float wave_sum(float v) {
#pragma unroll
    for (int o = 1; o < 64; o <<= 1) v += __shfl_xor(v, o);
    return v;
}
__device__ __forceinline__ float wave_max(float v) {
#pragma unroll
    for (int o = 1; o < 64; o <<= 1) v = fmaxf(v, __shfl_xor(v, o));
    return v;
}
__device__ __forceinline__ double wave_sum_d(double v) {
#pragma unroll
    for (int o = 1; o < 64; o <<= 1) v += __shfl_xor(v, o);
    return v;
}

#ifndef BG_IN_ATTN
#define BG_IN_ATTN 1
#endif
#ifndef BG_IN_PROLOGUE
#define BG_IN_PROLOGUE 0
#endif
#ifndef GEMM_SP2
#define GEMM_SP2 true
#endif
#ifndef EPI_TWICE
#define EPI_TWICE 0
#endif
#ifndef MOE_WGM
#define MOE_WGM 8
#endif
#ifndef FP8_EMU
#define FP8_EMU 0
#endif
__device__ __forceinline__ void q8pair(float& a, float& b, float sc) {
    float x = fminf(fmaxf(a * sc, -448.f), 448.f), y = fminf(fmaxf(b * sc, -448.f), 448.f);
    const int p = __builtin_amdgcn_cvt_pk_fp8_f32(x, y, 0, false); const float is = 1.0f / sc;
    a = __builtin_amdgcn_cvt_f32_fp8(p, 0) * is; b = __builtin_amdgcn_cvt_f32_fp8(p, 1) * is;
}
__device__ __forceinline__ f32x4 q8v(f32x4 v, float sc) { float a = v[0], b = v[1], c = v[2], d = v[3]; q8pair(a, b, sc); q8pair(c, d, sc); return (f32x4){a, b, c, d}; }
__device__ __forceinline__ unsigned pack4_fp8(float a, float b, float c, float d) {
    a = fminf(fmaxf(a, -448.f), 448.f); b = fminf(fmaxf(b, -448.f), 448.f); c = fminf(fmaxf(c, -448.f), 448.f); d = fminf(fmaxf(d, -448.f), 448.f);
    int p = __builtin_amdgcn_cvt_pk_fp8_f32(a, b, 0, false); p = __builtin_amdgcn_cvt_pk_fp8_f32(c, d, p, true); return (unsigned)p; }
typedef short s16x2_t __attribute__((ext_vector_type(2)));
__device__ __forceinline__ unsigned pack4_fp8_sc(float a, float b, float c, float d, float inv) {
    const s16x2_t lo = __builtin_amdgcn_cvt_scalef32_pk_fp8_f32((s16x2_t){0, 0}, a, b, inv, false);
    return __builtin_bit_cast(unsigned, __builtin_amdgcn_cvt_scalef32_pk_fp8_f32(lo, c, d, inv, true)); }
#define LDS_WAIT() asm volatile("s_waitcnt lgkmcnt(0)" ::: "memory")
#define VM_WAIT() asm volatile("s_waitcnt vmcnt(0)" ::: "memory")

namespace pg8 {
constexpr int BM = 256, BK = 64, HALF = 128, HTB = HALF * BK * 2, STAGE_BYTES = 8 * HTB, NXCD = 8, WGM = 8;
__host__ __device__ __forceinline__ int lds_byte(int r, int c) { const int st = (r >> 4) * 2 + (c >> 5), rr = r & 15, cc = c & 31, ob = rr * 64 + cc * 2; return st * 1024 + (ob ^ (((ob >> 9) & 1) << 5)); }
__host__ __device__ __forceinline__ void stage_rc(int b, int& Rr, int& C) { const int st = b / 1024, sb = b % 1024, swz = sb ^ (((sb >> 9) & 1) << 5); Rr = (st >> 1) * 16 + swz / 64; C = (st & 1) * 32 + (swz % 64) / 2; }
__host__ __device__ __forceinline__ int perm32(int rho) { const int n = rho >> 4, i = rho & 15; return 8 * (i >> 2) + 4 * n + (i & 3); }

struct Unit { int pm, pn, e, ks, nvalid, aux; const char* A; const char* B; };

__device__ __forceinline__ bool tile_order(int i, int G, int c, int nM, int nN, int& pm, int& pn) {
    const int nwg = nM * nN; const long L = (long)i * G + c; if (L >= nwg) return false;
    int wgid = (int)L; { const int q = nwg / NXCD, r = nwg % NXCD, xcd = wgid % NXCD, off = wgid / NXCD; wgid = (xcd < r ? xcd * (q + 1) : r * (q + 1) + (xcd - r) * q) + off; }
    const int nig = WGM * nN, gid = wgid / nig, fm = gid * WGM, gsz = (nM - fm) < WGM ? (nM - fm) : WGM;
    pm = fm + ((wgid % nig) % gsz); pn = (wgid % nig) / gsz; return true;
}
template <int KIND> struct DenseSched {
    int nM, nN, G, c, pm0; const char* A; const char* B; size_t a_tile, b_tile;
    __device__ __forceinline__ bool next(int i, Unit& u) const {
        int pm, pn; if (!tile_order(i, G, c, nM, nN, pm, pn)) return false;
        u.pm = pm + pm0; u.pn = pn; u.e = 0; u.ks = 0; u.nvalid = 256; u.aux = 0;
        size_t aoff = 0; if (KIND == 1) aoff = pn >= 6 ? 1024 : 0; if (KIND == 2) aoff = (size_t)(pn >> 1) * 1024;
        u.A = A + (size_t)(pm + pm0) * a_tile + aoff; u.B = B + (size_t)pn * b_tile; return true;
    }
};
template <int DOWN> struct MoeSched {
    const volatile LAS int* mt; int G, c, nNx; const char* A; const char* B; size_t a_row, b_exp, b_tile, ks_bytes;
    __device__ __forceinline__ int rd(int i) const { return __builtin_amdgcn_readfirstlane(mt[i]); }
    __device__ __forceinline__ bool next(int i, Unit& u) const {
        const int U = rd(24); const long L = (long)i * G + c; if (L >= U) return false;
        int idx = (int)L; { const int q = U / NXCD, r = U % NXCD, xcd = idx % NXCD, off = idx / NXCD; idx = (xcd < r ? xcd * (q + 1) : r * (q + 1) + (xcd - r) * q) + off; }
        int e = 0;
#pragma unroll
        for (int j = 1; j < 8; ++j) if (idx >= rd(16 + j)) e = j;
        constexpr int GM = MOE_WGM; const int l = idx - rd(16 + e), nM = rd(8 + e), nig = GM * nNx, gid = l / nig, fm = gid * GM, gsz = (nM - fm) < GM ? (nM - fm) : GM;
        const int pml = fm + ((l % nig) % gsz), jn = (l % nig) / gsz, pm = DOWN ? pml + rd(40 + e) : pml;
        u.pm = pm; u.e = e; u.nvalid = rd(e) - pm * 256; u.aux = DOWN ? rd(48 + e) + pml : 0;
        if (DOWN) { u.pn = jn & 7; u.ks = jn >> 3; u.A = A + (size_t)(rd(32 + e) + pm * 256) * a_row + (size_t)u.ks * ks_bytes; u.B = B + (size_t)e * b_exp + (size_t)u.pn * b_tile + (size_t)u.ks * ks_bytes; }
        else { u.pn = jn; u.ks = 0; u.A = A + (size_t)(e * CAP + pm * 256) * a_row; u.B = B + (size_t)e * b_exp + (size_t)jn * b_tile; }
        return true;
    }
};

typedef f32x4 Acc[2][2][4][2];
typedef int i32x8 __attribute__((ext_vector_type(8)));
typedef int i32x4 __attribute__((ext_vector_type(4)));
__device__ __forceinline__ i32x8 cat8(bf16x8 lo, bf16x8 hi) { const i32x4 a = __builtin_bit_cast(i32x4, lo), b = __builtin_bit_cast(i32x4, hi); return __builtin_shufflevector(a, b, 0, 1, 2, 3, 4, 5, 6, 7); }

typedef double f64x2 __attribute__((ext_vector_type(2)));
__device__ __forceinline__ f32x4 zero4() { f64x2 z; asm volatile("v_mov_b64 %0, 0" : "=v"(z.x)); asm volatile("v_mov_b64 %0, 0" : "=v"(z.y)); return __builtin_bit_cast(f32x4, z); }
template <bool FP8 = false, bool SP2 = GEMM_SP2, class Epi, class Sched>
__device__ __forceinline__ void gemm_phase(LAS unsigned char* lds, const int K, const int lda, const int ldb, const Sched& S, const Epi& E) {
    const int tid = threadIdx.x, wid = __builtin_amdgcn_readfirstlane(tid >> 6), lane = tid & 63, wr = wid >> 2, wc = wid & 3, fr = lane & 15, fq = lane >> 4;
    const int nt = K / BK;
    unsigned voffA[2], voffB[2];
#pragma unroll
    for (int i = 0; i < 2; ++i) { int Rr, C; stage_rc(tid * 16 + i * 8192, Rr, C); const int Rb = (Rr & ~31) + perm32(Rr & 31);
        voffA[i] = (unsigned)(Rr * lda + C) * 2u; voffB[i] = (unsigned)(Rb * ldb + C) * 2u; }
    const size_t kstep = (size_t)(BK * 2);
    const size_t hstepA = (size_t)HALF * lda * 2, hstepB = (size_t)HALF * ldb * 2;
    const unsigned ldsw = (unsigned)wid * 1024u;
    const int aoff = lds_byte(wr * 64 + fr, fq * 8), boff = lds_byte(wc * 32 + fr, fq * 8);
#define PG8_SA(b, h) (((b) * 2 + (h)) * HTB)
#define PG8_SB(b, h) ((4 + (b) * 2 + (h)) * HTB)
#define PG8_STAGE(bufoff, gbase, voff) do { _Pragma("unroll") for (int _i = 0; _i < 2; ++_i) \
        __builtin_amdgcn_global_load_lds((const unsigned*)((const char*)(gbase) + (voff)[_i]), (LAS unsigned*)(lds + (bufoff) + ldsw + _i * 8192), 16, 0, 0); } while (0)
#define PG8_LD8(p) __builtin_shufflevector(*(const LAS i32x4*)(p), *(const LAS i32x4*)((p) + 1024), 0, 1, 2, 3, 4, 5, 6, 7)
#define PG8_LDA(dst, b, h) do { if constexpr (FP8) { _Pragma("unroll") for (int m = 0; m < 4; ++m) dst##8[m] = PG8_LD8(lds + PG8_SA(b, h) + aoff + m * 2048); } \
        else { _Pragma("unroll") for (int m = 0; m < 4; ++m) _Pragma("unroll") for (int k = 0; k < 2; ++k) dst[m][k] = *(const LAS bf16x8*)(lds + PG8_SA(b, h) + aoff + m * 2048 + k * 1024); } } while (0)
#define PG8_LDB(dst, b, h) do { if constexpr (FP8) { _Pragma("unroll") for (int n = 0; n < 2; ++n) dst##8[n] = PG8_LD8(lds + PG8_SB(b, h) + boff + n * 2048); } \
        else { _Pragma("unroll") for (int n = 0; n < 2; ++n) _Pragma("unroll") for (int k = 0; k < 2; ++k) dst[n][k] = *(const LAS bf16x8*)(lds + PG8_SB(b, h) + boff + n * 2048 + k * 1024); } } while (0)
#define PG8_MMA(ai, bj, At, Bt) do { __builtin_amdgcn_s_setprio(1); _Pragma("unroll") for (int m = 0; m < 4; ++m) _Pragma("unroll") for (int n = 0; n < 2; ++n) { \
        if constexpr (FP8) asm volatile("v_mfma_scale_f32_16x16x128_f8f6f4 %0, %1, %2, %0, %3, %3 op_sel_hi:[0,0,0]" : "+v"(acc[ai][bj][m][n]) : "v"(Bt##8[n]), "v"(At##8[m]), "v"(one8)); \
        else { _Pragma("unroll") for (int k = 0; k < 2; ++k) acc[ai][bj][m][n] = __builtin_amdgcn_mfma_f32_16x16x32_bf16(Bt[n][k], At[m][k], acc[ai][bj][m][n], 0, 0, 0); } } __builtin_amdgcn_s_setprio(0); } while (0)
#define PG8_WAIT_V(n) asm volatile("s_waitcnt vmcnt(" #n ")" ::: "memory")
#define PG8_WAIT_L(n) asm volatile("s_waitcnt lgkmcnt(" #n ")" ::: "memory")
#define PG8_BAR __builtin_amdgcn_s_barrier()
#define PG8_SCHED __builtin_amdgcn_sched_barrier(0)
    Unit cur, nxt; int ui = 0;
    if (!S.next(0, cur)) return;
    Acc acc;
#pragma unroll
    for (int a = 0; a < 2; ++a)
#pragma unroll
        for (int b = 0; b < 2; ++b)
#pragma unroll
            for (int m = 0; m < 4; ++m)
#pragma unroll
                for (int n = 0; n < 2; ++n) acc[a][b][m][n] = (f32x4){0.f, 0.f, 0.f, 0.f};
    bf16x8 At[4][2], B0[2][2], B1[2][2];
    const int one8 = 0x7f7f7f7f;
    i32x8 At8[4], B08[2], B18[2];
    const char* cA = cur.A; const char* cB = cur.B;
    if constexpr (SP2) {
    PG8_STAGE(PG8_SB(0, 0), cB, voffB); PG8_STAGE(PG8_SB(0, 1), cB + hstepB, voffB); PG8_STAGE(PG8_SA(0, 0), cA, voffA); PG8_STAGE(PG8_SA(0, 1), cA + hstepA, voffA);
    if (wr == 1) PG8_BAR;
    PG8_WAIT_V(2); PG8_BAR;
    PG8_STAGE(PG8_SB(1, 0), cB + kstep, voffB); PG8_STAGE(PG8_SA(1, 0), cA + kstep, voffA); PG8_STAGE(PG8_SB(1, 1), cB + hstepB + kstep, voffB);
    PG8_WAIT_V(6); PG8_BAR;
    } else {
    PG8_STAGE(PG8_SB(0, 0), cB, voffB); PG8_STAGE(PG8_SA(0, 0), cA, voffA); PG8_STAGE(PG8_SB(0, 1), cB + hstepB, voffB); PG8_STAGE(PG8_SA(0, 1), cA + hstepA, voffA);
    if (wr == 1) PG8_BAR;
    PG8_WAIT_V(4); PG8_BAR;
    PG8_STAGE(PG8_SB(1, 0), cB + kstep, voffB); PG8_STAGE(PG8_SA(1, 0), cA + kstep, voffA); PG8_STAGE(PG8_SB(1, 1), cB + hstepB + kstep, voffB);
    PG8_WAIT_V(6); PG8_BAR;
    }
    for (;;) {
        const bool has_next = S.next(ui + 1, nxt);
        const char* nA = has_next ? nxt.A : cA; const char* nB = has_next ? nxt.B : cB;
        for (int t = 0; t < nt; t += 2) {
            const bool last = (t == nt - 2);
            const char* a1 = cA + (size_t)(t + 1) * kstep;
            const char* a2 = last ? nA : cA + (size_t)(t + 2) * kstep; const char* b2 = last ? nB : cB + (size_t)(t + 2) * kstep;
            const char* a3 = a2 + kstep; const char* b3 = b2 + kstep;
            if constexpr (SP2) {
            PG8_LDB(B0, 0, 0); PG8_LDB(B1, 0, 1); PG8_SCHED; PG8_LDA(At, 0, 0); PG8_STAGE(PG8_SA(1, 1), a1 + hstepA, voffA);
            PG8_WAIT_V(8); PG8_WAIT_L(0); PG8_BAR; PG8_MMA(0, 0, At, B0); PG8_MMA(0, 1, At, B1); PG8_BAR; PG8_SCHED;
            PG8_LDA(At, 0, 1); PG8_STAGE(PG8_SB(0, 0), b2, voffB); PG8_STAGE(PG8_SB(0, 1), b2 + hstepB, voffB); PG8_STAGE(PG8_SA(0, 0), a2, voffA);
            PG8_WAIT_V(8); PG8_WAIT_L(0); PG8_BAR; PG8_MMA(1, 0, At, B0); PG8_MMA(1, 1, At, B1); PG8_BAR; PG8_SCHED;
            PG8_LDB(B0, 1, 0); PG8_LDB(B1, 1, 1); PG8_SCHED; PG8_LDA(At, 1, 0); PG8_STAGE(PG8_SA(0, 1), a2 + hstepA, voffA);
            PG8_WAIT_V(8); PG8_WAIT_L(0); PG8_BAR; PG8_MMA(0, 0, At, B0); PG8_MMA(0, 1, At, B1); PG8_BAR; PG8_SCHED;
            PG8_LDA(At, 1, 1); PG8_STAGE(PG8_SB(1, 0), b3, voffB); PG8_STAGE(PG8_SB(1, 1), b3 + hstepB, voffB); PG8_STAGE(PG8_SA(1, 0), a3, voffA);
            PG8_WAIT_V(8); PG8_WAIT_L(0); PG8_BAR; PG8_MMA(1, 0, At, B0); PG8_MMA(1, 1, At, B1); PG8_BAR; PG8_SCHED;
            } else {
            PG8_LDB(B0, 0, 0); PG8_SCHED; PG8_LDA(At, 0, 0); PG8_STAGE(PG8_SA(1, 1), a1 + hstepA, voffA);
            PG8_WAIT_L(8); PG8_BAR; PG8_WAIT_L(0); PG8_MMA(0, 0, At, B0); PG8_BAR; PG8_SCHED;
            PG8_LDB(B1, 0, 1); PG8_STAGE(PG8_SB(0, 0), b2, voffB);
            PG8_BAR; PG8_WAIT_L(0); PG8_MMA(0, 1, At, B1); PG8_BAR;
            PG8_LDA(At, 0, 1); PG8_STAGE(PG8_SA(0, 0), a2, voffA);
            PG8_BAR; PG8_WAIT_L(0); PG8_MMA(1, 0, At, B0); PG8_BAR; PG8_SCHED;
            PG8_STAGE(PG8_SB(0, 1), b2 + hstepB, voffB);
            PG8_WAIT_V(6); PG8_BAR; PG8_MMA(1, 1, At, B1); PG8_BAR;
            PG8_LDB(B0, 1, 0); PG8_SCHED; PG8_LDA(At, 1, 0); PG8_STAGE(PG8_SA(0, 1), a2 + hstepA, voffA);
            PG8_WAIT_L(8); PG8_BAR; PG8_WAIT_L(0); PG8_MMA(0, 0, At, B0); PG8_BAR; PG8_SCHED;
            PG8_LDB(B1, 1, 1); PG8_STAGE(PG8_SB(1, 0), b3, voffB);
            PG8_BAR; PG8_WAIT_L(0); PG8_MMA(0, 1, At, B1); PG8_BAR;
            PG8_LDA(At, 1, 1); PG8_STAGE(PG8_SA(1, 0), a3, voffA);
            PG8_BAR; PG8_WAIT_L(0); PG8_MMA(1, 0, At, B0); PG8_BAR; PG8_SCHED;
            PG8_STAGE(PG8_SB(1, 1), b3 + hstepB, voffB);
            PG8_WAIT_V(6); PG8_BAR; PG8_MMA(1, 1, At, B1); PG8_BAR;
            }
        }
        if constexpr (FP8) asm volatile("s_nop 15\n\ts_nop 15" ::: "memory");
        if (wr == 0) PG8_BAR;
        { int fr2 = fr, fq2 = fq; asm volatile("" : "+v"(fr2), "+v"(fq2)); E(acc, cur, wr, wc, fr2, fq2); if constexpr (FP8 && EPI_TWICE) { asm volatile("" : "+v"(fr2), "+v"(fq2)); E(acc, cur, wr, wc, fr2, fq2); } }
        if (!has_next) break;
#pragma unroll
        for (int a = 0; a < 2; ++a)
#pragma unroll
            for (int b = 0; b < 2; ++b)
#pragma unroll
                for (int m = 0; m < 4; ++m)
#pragma unroll
                    for (int n = 0; n < 2; ++n) acc[a][b][m][n] = zero4();
        cur = nxt; cA = nA; cB = nB; ++ui;
        if (wr == 1) PG8_BAR;
    }
    PG8_WAIT_V(0);
    PG8_BAR;
#undef PG8_SA
#undef PG8_SB
#undef PG8_STAGE
#undef PG8_LDA
#undef PG8_LD8
#undef PG8_LDB
#undef PG8_MMA
#undef PG8_WAIT_V
#undef PG8_WAIT_L
#undef PG8_BAR
#undef PG8_SCHED
}

#define EPI_ROWS _Pragma("unroll") for (int ai = 0; ai < 2; ++ai) _Pragma("unroll") for (int m = 0; m < 4; ++m)
#define EPI_RL (ai * 128 + wr * 64 + m * 16 + fr)

struct EpiIn {
    unsigned char* ws; const float* fbias;
    __device__ __forceinline__ void operator()(const Acc& acc, const Unit& u, int wr, int wc, int fr, int fq) const {
        const int pn = u.pn, c8 = wc * 32 + fq * 8;
        bf16_t* cqkv = (bf16_t*)(ws + WS_L_CQKV); float* ssq = (float*)(ws + WS_SSQ); float* kr = (float*)(ws + WS_L_KR); float* lf = (float*)(ws + WS_L_LF);
        if (pn < 4) {
            EPI_ROWS { const int row = u.pm * 256 + EPI_RL; float s = 0.f;
#pragma unroll
                for (int bj = 0; bj < 2; ++bj) { const f32x4 v0 = acc[ai][bj][m][0], v1 = acc[ai][bj][m][1];
                    *(u32x4*)(cqkv + (size_t)row * 1024 + pn * 256 + bj * 128 + c8) = pack8(v0, v1);
                    float t = v0[0] * v0[0] + v0[1] * v0[1] + v0[2] * v0[2] + v0[3] * v0[3] + v1[0] * v1[0] + v1[1] * v1[1] + v1[2] * v1[2] + v1[3] * v1[3];
                    t += __shfl_xor(t, 16); t += __shfl_xor(t, 32); s += t; }
                if (fq == 0) ssq[((size_t)(pn >> 1) * R + row) * 8 + (pn & 1) * 4 + wc] = s; }
        } else if (pn < 16) {
            const size_t toff = pn < 8 ? WS_L_QP : (pn < 12 ? WS_L_KP : WS_L_VP); bf16_t* T = (bf16_t*)(ws + toff); const int t = (pn - 4) & 3, width = pn < 12 ? DKP : DV; const float sc = pn < 8 ? QS_FOX : 1.f;
            EPI_ROWS { const int row = u.pm * 256 + EPI_RL;
#pragma unroll
                for (int bj = 0; bj < 2; ++bj) { const int head = 8 + 2 * t + bj;
                    *(u32x4*)(T + ((size_t)head * R + row) * width + c8) = pack8(acc[ai][bj][m][0] * sc, acc[ai][bj][m][1] * sc); } }
        } else {
            EPI_ROWS { const int row = u.pm * 256 + EPI_RL; const f32x4 v0 = acc[ai][0][m][0], v1 = acc[ai][0][m][1];
                if (wc < 2) { *(f32x4*)(kr + (size_t)row * 64 + c8) = v0; *(f32x4*)(kr + (size_t)row * 64 + c8 + 4) = v1; }
                else if (wc == 2 && fq == 0) { f32x4 o0, o1;
#pragma unroll
                    for (int j = 0; j < 4; ++j) { const float x0 = v0[j] + fbias[j], x1 = v1[j] + fbias[4 + j];
                        o0[j] = fminf(x0, 0.f) - log1pf(expf(-fabsf(x0))); o1[j] = fminf(x1, 0.f) - log1pf(expf(-fabsf(x1))); }
                    *(f32x4*)(lf + (size_t)row * 8) = o0; *(f32x4*)(lf + (size_t)row * 8 + 4) = o1; } }
        }
    }
};
struct EpiUp {
    const float* ssq; const float* cs; bf16_t *qp, *kp, *vp;
    __device__ __forceinline__ void operator()(const Acc& acc, const Unit& u, int wr, int wc, int fr, int fq) const {
        const int pn = u.pn, c8 = wc * 32 + fq * 8, which = pn < 6 ? 0 : 1;
        EPI_ROWS { const int row = u.pm * 256 + EPI_RL;
            const f32x4 s0 = *(const f32x4*)(ssq + ((size_t)which * R + row) * 8), s1 = *(const f32x4*)(ssq + ((size_t)which * R + row) * 8 + 4);
            const float ss = ((s0[0] + s0[1]) + (s0[2] + s0[3])) + ((s1[0] + s1[1]) + (s1[2] + s1[3]));
            const float rr = 1.0f / sqrtf(ss * (1.0f / 512.0f) + RMS_EPS);
            if (pn < 4) { const float sc = rr * QS_MLA;
#pragma unroll
                for (int bj = 0; bj < 2; ++bj) *(u32x4*)(qp + ((size_t)(2 * pn + bj) * R + row) * DKP + c8) = pack8(acc[ai][bj][m][0] * sc, acc[ai][bj][m][1] * sc);
            } else if (pn < 6) { const float sc = rr * QS_MLA; const int q8 = 4 * (wc & 1) + fq;
                const f32x4 C = *(const f32x4*)(cs + (size_t)row * 64 + 4 * q8), Sn = *(const f32x4*)(cs + (size_t)row * 64 + 32 + 4 * q8);
#pragma unroll
                for (int bj = 0; bj < 2; ++bj) { const int head = 4 * (pn - 4) + 2 * bj + (wc >> 1); const f32x4 x1 = acc[ai][bj][m][0] * sc, x2 = acc[ai][bj][m][1] * sc;
                    bf16_t* q = qp + ((size_t)head * R + row) * DKP + 128 + 4 * q8;
                    *(u32x2*)q = pack4(x1 * C - x2 * Sn); *(u32x2*)(q + 32) = pack4(x2 * C + x1 * Sn); }
            } else if (pn < 10) {
#pragma unroll
                for (int bj = 0; bj < 2; ++bj) *(u32x4*)(kp + ((size_t)(2 * (pn - 6) + bj) * R + row) * DKP + c8) = pack8(acc[ai][bj][m][0] * rr, acc[ai][bj][m][1] * rr);
            } else {
#pragma unroll
                for (int bj = 0; bj < 2; ++bj) *(u32x4*)(vp + ((size_t)(2 * (pn - 10) + bj) * R + row) * DV + c8) = pack8(acc[ai][bj][m][0] * rr, acc[ai][bj][m][1] * rr);
            }
        }
    }
};
template <int MODE> struct EpiRes {
    float* Y; const float* stats; const float* x; const float* meta; const float* g; const float* b;
    __device__ __forceinline__ void operator()(const Acc& acc, const Unit& u, int wr, int wc, int fr, int fq) const {
        const int c8 = wc * 32 + fq * 8;
        EPI_ROWS { const int row = u.pm * 256 + EPI_RL;
            const float* rp; float mean = 0.f, rstd = 0.f;
            if (MODE == 1) { rp = Y + (size_t)row * DM; const f32x2 st = *(const f32x2*)(stats + (size_t)row * 2); mean = st.x; rstd = st.y; }
            else rp = row >= ROW0 ? x + (size_t)(row - ROW0) * DM : (row >= PADR ? meta + (size_t)(row - PADR) * DM : nullptr);
#pragma unroll
            for (int bj = 0; bj < 2; ++bj) { const int col = u.pn * 256 + bj * 128 + c8;
                f32x4 r0 = (f32x4){0.f, 0.f, 0.f, 0.f}, r1 = r0; if (MODE == 1 || rp) { r0 = *(const f32x4*)(rp + col); r1 = *(const f32x4*)(rp + col + 4); }
                if (MODE == 1) {
                    r0 = (r0 - mean) * rstd * *(const f32x4*)(g + col) + *(const f32x4*)(b + col); r1 = (r1 - mean) * rstd * *(const f32x4*)(g + col + 4) + *(const f32x4*)(b + col + 4); }
                *(f32x4*)(Y + (size_t)row * DM + col) = r0 * ALPHA + acc[ai][bj][m][0]; *(f32x4*)(Y + (size_t)row * DM + col + 4) = r1 * ALPHA + acc[ai][bj][m][1]; }
        }
    }
};
struct EpiResStat {
    float* Y; const float* stats; const float* g; const float* b; bf16_t* Y16; float* slots; LAS unsigned char* lds;
    __device__ __forceinline__ void operator()(const Acc& acc, const Unit& u, int wr, int wc, int fr, int fq) const {
        const int c8 = wc * 32 + fq * 8; LAS f32x2* P = (LAS f32x2*)(lds + LDS_PSTAT);
        EPI_ROWS { const int rl = EPI_RL, row = u.pm * 256 + rl; float* rp = Y + (size_t)row * DM; const f32x2 st = *(const f32x2*)(stats + (size_t)row * 2); float sm = 0.f, sq = 0.f;
#pragma unroll
            for (int bj = 0; bj < 2; ++bj) { const int col = u.pn * 256 + bj * 128 + c8;
                f32x4 r0 = *(const f32x4*)(rp + col), r1 = *(const f32x4*)(rp + col + 4);
                r0 = (r0 - st.x) * st.y * *(const f32x4*)(g + col) + *(const f32x4*)(b + col); r1 = (r1 - st.x) * st.y * *(const f32x4*)(g + col + 4) + *(const f32x4*)(b + col + 4);
                const f32x4 y0 = r0 * ALPHA + acc[ai][bj][m][0], y1 = r1 * ALPHA + acc[ai][bj][m][1];
                *(f32x4*)(rp + col) = y0; *(f32x4*)(rp + col + 4) = y1; *(u32x4*)(Y16 + (size_t)row * DM + col) = pack8(y0, y1);
                sm += ((y0[0] + y0[1]) + (y0[2] + y0[3])) + ((y1[0] + y1[1]) + (y1[2] + y1[3]));
                sq += ((y0[0] * y0[0] + y0[1] * y0[1]) + (y0[2] * y0[2] + y0[3] * y0[3])) + ((y1[0] * y1[0] + y1[1] * y1[1]) + (y1[2] * y1[2] + y1[3] * y1[3])); }
            sm += __shfl_xor(sm, 16); sm += __shfl_xor(sm, 32); sq += __shfl_xor(sq, 16); sq += __shfl_xor(sq, 32);
            if (fq == 0) P[rl * 4 + wc] = (f32x2){sm, sq}; }
        asm volatile("s_waitcnt lgkmcnt(0)" ::: "memory"); __builtin_amdgcn_s_barrier(); asm volatile("" ::: "memory");
        const int t = threadIdx.x;
        if (t < 256) { const f32x2 a = P[t * 4 + 0], bb = P[t * 4 + 1], c = P[t * 4 + 2], d = P[t * 4 + 3];
            *(f32x2*)(slots + ((size_t)(u.pm * 256 + t) * 8 + u.pn) * 2) = (f32x2){(a.x + bb.x) + (c.x + d.x), (a.y + bb.y) + (c.y + d.y)}; }
    }
};
struct EpiPoolIn {
    bf16_t* HP; const float* slots; const float* c1; const float* c2; float* stats;
    __device__ __forceinline__ void operator()(const Acc& acc, const Unit& u, int wr, int wc, int fr, int fq) const {
        const int c8 = wc * 32 + fq * 8;
        EPI_ROWS { const int row = u.pm * 256 + EPI_RL; const f32x4* sp = (const f32x4*)(slots + (size_t)row * 16); const f32x4 a = sp[0], bb = sp[1], c = sp[2], d = sp[3];
            const float S = ((a[0] + a[2]) + (bb[0] + bb[2])) + ((c[0] + c[2]) + (d[0] + d[2])), Q = ((a[1] + a[3]) + (bb[1] + bb[3])) + ((c[1] + c[3]) + (d[1] + d[3]));
            const float mean = S * (1.0f / DM), var = Q * (1.0f / DM) - mean * mean, rstd = 1.0f / sqrtf(var + LN_EPS);
            if (u.pn == 0 && wc == 0 && fq == 0) *(f32x2*)(stats + (size_t)row * 2) = (f32x2){mean, rstd};
#pragma unroll
            for (int bj = 0; bj < 2; ++bj) { const int col = u.pn * 256 + bj * 128 + c8;
                const f32x4 v0 = (acc[ai][bj][m][0] - *(const f32x4*)(c1 + col) * mean) * rstd + *(const f32x4*)(c2 + col);
                const f32x4 v1 = (acc[ai][bj][m][1] - *(const f32x4*)(c1 + col + 4) * mean) * rstd + *(const f32x4*)(c2 + col + 4);
                *(u32x4*)(HP + (size_t)row * DM + col) = pack8(v0, v1); } }
    }
};
__device__ __forceinline__ float silu_mul(float g, float uu) { return g * __builtin_amdgcn_rcpf(1.0f + __builtin_amdgcn_exp2f(-g * LOG2E)) * uu; }
__device__ __forceinline__ f32x4 silu_mul4(f32x4 g, f32x4 uu, float cg, float cu) {
    const f32x4 t = g * (-cg * LOG2E); f32x4 e;
    e[0] = __builtin_amdgcn_exp2f(t[0]); e[1] = __builtin_amdgcn_exp2f(t[1]); e[2] = __builtin_amdgcn_exp2f(t[2]); e[3] = __builtin_amdgcn_exp2f(t[3]);
    const f32x4 sden = e + 1.0f; f32x4 r;
    r[0] = __builtin_amdgcn_rcpf(sden[0]); r[1] = __builtin_amdgcn_rcpf(sden[1]); r[2] = __builtin_amdgcn_rcpf(sden[2]); r[3] = __builtin_amdgcn_rcpf(sden[3]);
    return (g * uu) * (r * (cg * cu));
}
__device__ __forceinline__ f32x4 silu_mul4_raw(f32x4 g, f32x4 uu, float kt) {
    const f32x4 t = g * kt; f32x4 e;
    e[0] = __builtin_amdgcn_exp2f(t[0]); e[1] = __builtin_amdgcn_exp2f(t[1]); e[2] = __builtin_amdgcn_exp2f(t[2]); e[3] = __builtin_amdgcn_exp2f(t[3]);
    const f32x4 sden = e + 1.0f; f32x4 r;
    r[0] = __builtin_amdgcn_rcpf(sden[0]); r[1] = __builtin_amdgcn_rcpf(sden[1]); r[2] = __builtin_amdgcn_rcpf(sden[2]); r[3] = __builtin_amdgcn_rcpf(sden[3]);
    return (g * uu) * r;
}
struct EpiGU {
    bf16_t* act; int ld;
    __device__ __forceinline__ void operator()(const Acc& acc, const Unit& u, int wr, int wc, int fr, int fq) const {
        const int c8 = wc * 32 + fq * 8; const int rbase = u.pm * 256;
        EPI_ROWS { const int row = rbase + EPI_RL; const f32x4 g0 = acc[ai][0][m][0], g1 = acc[ai][0][m][1], u0 = acc[ai][1][m][0], u1 = acc[ai][1][m][1]; f32x4 a0, a1;
            a0 = silu_mul4(g0, u0, 1.0f, 1.0f); a1 = silu_mul4(g1, u1, 1.0f, 1.0f);
            if (FP8_EMU) { a0 = q8v(a0, 4.f); a1 = q8v(a1, 4.f); }
            *(u32x4*)(act + (size_t)row * ld + u.pn * 128 + c8) = pack8(a0, a1); }
    }
};
struct EpiGU8 {
    unsigned char* act; const volatile LAS int* mt;
    __device__ __forceinline__ void operator()(const Acc& acc, const Unit& u, int wr, int wc, int fr, int fq) const {
        const int c8 = wc * 32 + fq * 8; const int rbase = __builtin_amdgcn_readfirstlane(mt[32 + u.e]) + u.pm * 256; constexpr float IS = 1.0f / (SX8 * SWGU8);
        EPI_ROWS { const int row = rbase + EPI_RL;
            const f32x4 a0 = silu_mul4_raw(acc[ai][0][m][0], acc[ai][1][m][0], -IS * LOG2E), a1 = silu_mul4_raw(acc[ai][0][m][1], acc[ai][1][m][1], -IS * LOG2E);
            constexpr float OS = 1.0f / (IS * IS * SACT8);
            u32x2 o; o.x = pack4_fp8_sc(a0[0], a0[1], a0[2], a0[3], OS); o.y = pack4_fp8_sc(a1[0], a1[1], a1[2], a1[3], OS);
            *(u32x2*)(act + (size_t)row * FE + u.pn * 128 + c8) = o; }
    }
};
struct EpiF32 { float* C;
    __device__ __forceinline__ void operator()(const Acc& acc, const Unit& u, int wr, int wc, int fr, int fq) const {
        const int c8 = wc * 32 + fq * 8;
        EPI_ROWS { const int row = u.pm * 256 + EPI_RL;
#pragma unroll
            for (int bj = 0; bj < 2; ++bj) { float* p = C + (size_t)row * DM + u.pn * 256 + bj * 128 + c8; *(f32x4*)p = acc[ai][bj][m][0]; *(f32x4*)(p + 4) = acc[ai][bj][m][1]; } }
    }
};
struct EpiBf { bf16_t* C;
    __device__ __forceinline__ void operator()(const Acc& acc, const Unit& u, int wr, int wc, int fr, int fq) const {
        const int c8 = wc * 32 + fq * 8;
        EPI_ROWS { const int row = u.pm * 256 + EPI_RL;
#pragma unroll
            for (int bj = 0; bj < 2; ++bj) *(u32x4*)(C + (size_t)row * DM + u.pn * 256 + bj * 128 + c8) = pack8(acc[ai][bj][m][0], acc[ai][bj][m][1]); }
    }
};
struct EpiMoeDown { bf16_t* ym; bf16_t* yx; const int* rinfo;
    __device__ __forceinline__ void operator()(const Acc& acc, const Unit& u, int wr, int wc, int fr, int fq) const {
        const int c8 = wc * 32 + fq * 8;
        EPI_ROWS { const int rl = EPI_RL;
            if (rl < u.nvalid) { bf16_t* p;
                if (u.ks == 0) { const int info = rinfo[u.e * CAP + u.pm * 256 + rl]; const int tok = info >> 1, k = info & 1; p = ym + ((size_t)k * SEQ + tok) * DM + u.pn * 256 + c8; }
                else p = yx + ((size_t)(u.ks - 1) * OVF_ROWS + u.aux * 256 + rl) * DM + u.pn * 256 + c8;
#pragma unroll
                for (int bj = 0; bj < 2; ++bj) *(u32x4*)(p + bj * 128) = pack8(acc[ai][bj][m][0] * (1.0f / (SACT8 * SWDN8)), acc[ai][bj][m][1] * (1.0f / (SACT8 * SWDN8))); } }
    }
};
}

#define XB_TMO      128
#define XB_XCNT(j)  (256  + 64 * (j))
#define XB_XSUB(j)  (1280 + 64 * (j))
#define XB_XGEN(j)  (2304 + 64 * (j))
#define XB_TOP      3328
#define XB_TOPGEN   3392
#define XCD_BAR_WORDS 3456
#define XB_SPIN_CAP (1u << 24)
__device__ __forceinline__ unsigned xb_ld(unsigned* p)              { return __hip_atomic_load(p, __ATOMIC_RELAXED, __HIP_MEMORY_SCOPE_AGENT); }
__device__ __forceinline__ unsigned xb_add(unsigned* p, unsigned v) { return __hip_atomic_fetch_add(p, v, __ATOMIC_RELAXED, __HIP_MEMORY_SCOPE_AGENT); }
__device__ __forceinline__ unsigned xb_xcc_id() { return (unsigned)__builtin_amdgcn_s_getreg((3 << 11) | 20) & 0xFu; }
#define XB_SPIN(cond, bar) do { unsigned _sp = 0; while (cond) { __builtin_amdgcn_s_sleep(1); \
    if ((++_sp & 255u) == 0u) { if (xb_ld(&(bar)[XB_TMO])) break; if (_sp > XB_SPIN_CAP) { atomicAdd(&(bar)[XB_TMO], 1u); break; } } } } while (0)
struct XcdBarrier { unsigned* bar; unsigned x; volatile LAS unsigned* st; };
__device__ __forceinline__ XcdBarrier xcd_barrier_post(unsigned* bar, volatile LAS unsigned* st) {
    XcdBarrier b; b.bar = bar; b.x = xb_xcc_id(); b.st = st;
    if (threadIdx.x == 0) (void)xb_add(&bar[XB_XCNT(b.x)], 1u);
    return b;
}
__device__ __forceinline__ void xcd_barrier_complete(unsigned* bar, unsigned x, unsigned& nloc, unsigned& nx) {
    const unsigned G = gridDim.x * gridDim.y * gridDim.z;
    unsigned sum, cnt, mine, sp = 0u;
    for (;;) {
        sum = 0u; cnt = 0u; mine = 0u;
#pragma unroll
        for (unsigned j = 0; j < 16; ++j) { const unsigned c = xb_ld(&bar[XB_XCNT(j)]); sum += c; cnt += (c > 0u) ? 1u : 0u; mine = (j == x) ? c : mine; }
        if (sum == G) break;
        __builtin_amdgcn_s_sleep(1);
        if ((++sp & 255u) == 0u) { if (xb_ld(&bar[XB_TMO])) break; if (sp > XB_SPIN_CAP) { atomicAdd(&bar[XB_TMO], 1u); break; } }
    }
    nloc = mine > 0u ? mine : 1u; nx = cnt > 0u ? cnt : 1u;
}
__device__ __forceinline__ void xcd_barrier(const XcdBarrier& b) {
    asm volatile("s_waitcnt vmcnt(0)" ::: "memory");
    __syncthreads();
    if (threadIdx.x == 0) {
        unsigned* bar = b.bar;
        __builtin_amdgcn_s_waitcnt(0);
        unsigned nloc = b.st[0], nx = b.st[1];
        if (nloc == 0u) { xcd_barrier_complete(bar, b.x, nloc, nx); b.st[0] = nloc; b.st[1] = nx; }
        const unsigned old = xb_add(&bar[XB_XSUB(b.x)], 1u);
        const unsigned gen = old / nloc;
        if (old + 1u == (gen + 1u) * nloc) {
            __builtin_amdgcn_fence(__ATOMIC_RELEASE, "agent");
            asm volatile("s_waitcnt vmcnt(0)" ::: "memory");
            const unsigned og = xb_add(&bar[XB_TOP], 1u);
            const unsigned tg = og / nx;
            if (og + 1u == (tg + 1u) * nx) xb_add(&bar[XB_TOPGEN], 1u);
            else XB_SPIN(xb_ld(&bar[XB_TOPGEN]) == tg, bar);
            __builtin_amdgcn_fence(__ATOMIC_ACQUIRE, "agent");
            xb_add(&bar[XB_XGEN(b.x)], 1u);
            asm volatile("s_waitcnt vmcnt(0)" ::: "memory");
        } else {
            XB_SPIN(xb_ld(&bar[XB_XGEN(b.x)]) == gen, bar);
            __builtin_amdgcn_fence(__ATOMIC_ACQUIRE, "agent");
            asm volatile("s_waitcnt vmcnt(0)" ::: "memory");
        }
    }
    __syncthreads();
}

struct Args { const float* in[25]; float* out; unsigned char* ws; int ph_lo, ph_hi; };
enum { I_X = 0, I_META, I_WIN, I_FBIAS, I_QNORM, I_KVNORM, I_WUQ, I_WUKV, I_WOUT, I_PWIN, I_PWGRP, I_PSCALE, I_PWOUT, I_FGATE, I_FUP, I_FDOWN, I_MROUTER, I_MBROUTER,
       I_MGATE, I_MUP, I_MDOWN, I_LNMG, I_LNMB, I_LNFG, I_LNFB };
struct Frame {
    LAS unsigned char* lds; volatile LAS int* MISC; unsigned* ctl; unsigned char* ws;
    int tid, lane, wave, vcu, G;
};
constexpr int NPHASE = 17;

enum { TK_PLAIN = 0, TK_IN, TK_UQ, TK_UKV, TK_GU };
__device__ __forceinline__ int t_srccol(int kind, int n) {
    switch (kind) {
        case TK_IN: return n < 1024 ? n : (n < 4096 ? n + 64 : (n < 4160 ? n - 3072 : (n < 4168 ? n : -1)));
        case TK_UQ: { if (n < 1024) return (n >> 7) * 192 + (n & 127); const int mm = n - 1024, h = mm >> 6, jj = mm & 63, q8 = jj >> 3, i = jj & 7;
                      return h * 192 + 128 + (i < 4 ? 4 * q8 + i : 32 + 4 * q8 + i - 4); }
        case TK_UKV: { if (n < 1024) return (n >> 7) * 256 + (n & 127); const int mm = n - 1024; return (mm >> 7) * 256 + 128 + (mm & 127); }
        case TK_GU: { const int p = n >> 8, r = n & 255; return 128 * p + (r & 127); }
        default: return n;
    }
}
struct TD { const float* W; const float* W2; const float* ksc; const float* nsc; bf16_t* WT; int K, Nsrc, kind, k0, n0, fp8; float wsc, q8; };
__device__ __forceinline__ void t_load(const TD& d, int lane, f32x2 (&v)[32]) {
    const int nd = d.n0 + 2 * (lane & 31); const int sc = t_srccol(d.kind, nd);
    const float* Ws = (d.kind == TK_GU && (nd & 128)) ? d.W2 : d.W;
    const float* p = Ws + (size_t)(d.k0 + (lane >> 5)) * d.Nsrc + (sc >= 0 ? sc : 0);
#pragma unroll
    for (int i = 0; i < 32; ++i) { v[i] = (f32x2){0.f, 0.f}; if (sc >= 0) v[i] = *(const f32x2*)(p + (size_t)(2 * i) * d.Nsrc); }
}
__device__ __forceinline__ void t_to_lds(int lane, const f32x2 (&v)[32], LAS float* scr) {
#pragma unroll
    for (int i = 0; i < 32; ++i) { const int kk = 2 * i + (lane >> 5); scr[kk * 65 + 2 * (lane & 31)] = v[i].x; scr[kk * 65 + 2 * (lane & 31) + 1] = v[i].y; }
}
__device__ __forceinline__ void t_store(const TD& d, int lane, LAS float* scr) {
    const int c = lane & 7;
    f32x4 ks0 = (f32x4){1.f, 1.f, 1.f, 1.f}, ks1 = ks0; if (d.ksc) { ks0 = *(const f32x4*)(d.ksc + d.k0 + 8 * c); ks1 = *(const f32x4*)(d.ksc + d.k0 + 8 * c + 4); }
#pragma unroll
    for (int j = 0; j < 8; ++j) { const int n = (lane >> 3) + 8 * j; const LAS float* s = scr + (8 * c) * 65 + n; const float ns = d.nsc ? d.nsc[d.n0 + n] : 1.f;
        f32x4 x0 = (f32x4){s[0 * 65], s[1 * 65], s[2 * 65], s[3 * 65]} * ks0 * ns, x1 = (f32x4){s[4 * 65], s[5 * 65], s[6 * 65], s[7 * 65]} * ks1 * ns;
        if (FP8_EMU && d.q8 > 0.f) { x0 = q8v(x0, d.q8); x1 = q8v(x1, d.q8); }
        *(u32x4*)(d.WT + (size_t)(d.n0 + n) * d.K + d.k0 + 8 * c) = pack8(x0, x1); }
}
__device__ __forceinline__ void t_load8(const TD& d, int lane, f32x2 (&v)[32]) {
    const int nd = d.n0 + 2 * (lane & 15); const int sc = t_srccol(d.kind, nd);
    const float* Ws = (d.kind == TK_GU && (nd & 128)) ? d.W2 : d.W;
    const float* p = Ws + (size_t)(d.k0 + (lane >> 4)) * d.Nsrc + sc;
#pragma unroll
    for (int i = 0; i < 32; ++i) v[i] = *(const f32x2*)(p + (size_t)(4 * i) * d.Nsrc);
}
__device__ __forceinline__ void t_to_lds8(int lane, const f32x2 (&v)[32], LAS float* scr) {
#pragma unroll
    for (int i = 0; i < 32; ++i) { const int kk = 4 * i + (lane >> 4); scr[kk * 33 + 2 * (lane & 15)] = v[i].x; scr[kk * 33 + 2 * (lane & 15) + 1] = v[i].y; }
}
__device__ __forceinline__ void t_store8(const TD& d, int lane, LAS float* scr) {
    const int c = lane & 7; unsigned char* WT8 = (unsigned char*)d.WT; const float ws = d.wsc;
#pragma unroll
    for (int j = 0; j < 4; ++j) { const int n = (lane >> 3) + 8 * j; const LAS float* s = scr + (16 * c) * 33 + n;
        u32x4 o; o.x = pack4_fp8(s[0 * 33] * ws, s[1 * 33] * ws, s[2 * 33] * ws, s[3 * 33] * ws); o.y = pack4_fp8(s[4 * 33] * ws, s[5 * 33] * ws, s[6 * 33] * ws, s[7 * 33] * ws);
        o.z = pack4_fp8(s[8 * 33] * ws, s[9 * 33] * ws, s[10 * 33] * ws, s[11 * 33] * ws); o.w = pack4_fp8(s[12 * 33] * ws, s[13 * 33] * ws, s[14 * 33] * ws, s[15 * 33] * ws);
        *(u32x4*)(WT8 + (size_t)(d.n0 + n) * d.K + d.k0 + 16 * c) = o; }
}

constexpr int BG_PER_EXPERT = 32 * 448, BG_GU_ITEMS = 8 * BG_PER_EXPERT;
constexpr int BG_DN_PER_EXPERT = 112 * 64, BG_DN_ITEMS = 31360;
constexpr int BG_FGU_ITEMS = 32 * 352, BG_FDN_ITEMS = 88 * 64;
constexpr int BG_J1 = BG_GU_ITEMS + BG_DN_ITEMS, BG_J2 = BG_J1 + BG_FGU_ITEMS, BG_ITEMS = BG_J2 + BG_FDN_ITEMS;
__device__ __forceinline__ void bg_issue(const Args& a, int j, LAS unsigned char* scr, int lane) {
    const float* W; int ld;
    if (j < BG_GU_ITEMS) { const int e = j / BG_PER_EXPERT, r = j - e * BG_PER_EXPERT, kb = r / 448, nb = r - kb * 448, n0 = nb * 32, p = n0 >> 8, r0 = n0 & 255;
        W = ((r0 & 128) ? a.in[I_MUP] : a.in[I_MGATE]) + (size_t)e * 2048 * FE + (size_t)(kb * 64) * FE + 128 * p + (r0 & 127); ld = FE; }
    else if (j < BG_J1) { const int jj = j - BG_GU_ITEMS, e = jj / BG_DN_PER_EXPERT, r = jj - e * BG_DN_PER_EXPERT, kb = r >> 6, nb = r & 63;
        W = a.in[I_MDOWN] + (size_t)e * FE * 2048 + (size_t)(kb * 64) * 2048 + nb * 32; ld = 2048; }
    else if (j < BG_J2) { const int r = j - BG_J1, kb = r / 352, nb = r - kb * 352, n0 = nb * 32, p = n0 >> 8, r0 = n0 & 255;
        W = ((r0 & 128) ? a.in[I_FUP] : a.in[I_FGATE]) + (size_t)(kb * 64) * FFN + 128 * p + (r0 & 127); ld = FFN; }
    else { const int r = j - BG_J2, kb = r >> 6, nb = r & 63; W = a.in[I_FDOWN] + (size_t)(kb * 64) * 2048 + nb * 32; ld = 2048; }
    const unsigned loff = (unsigned)((lane >> 3) * ld + (lane & 7) * 4) * 4u;
#pragma unroll
    for (int p8 = 0; p8 < 8; ++p8) __builtin_amdgcn_global_load_lds((const unsigned*)((const char*)(W + (size_t)(8 * p8) * ld) + loff), (LAS unsigned*)(scr + p8 * 1024), 16, 0, 0);
}
__device__ __forceinline__ void bg_flush(unsigned char* ws, int j, const LAS unsigned char* scr, int lane) {
    const int n = lane & 31, kh = lane >> 5; unsigned char* dst; float sc;
    if (j < BG_GU_ITEMS) { const int e = j / BG_PER_EXPERT, r = j - e * BG_PER_EXPERT, kb = r / 448, nb = r - kb * 448;
        dst = ws + WS_W_MGU + (size_t)e * 2 * FE * 2048 + (size_t)(nb * 32 + n) * 2048 + kb * 64 + 32 * kh; sc = 1.f / SWGU8; }
    else if (j < BG_J1) { const int jj = j - BG_GU_ITEMS, e = jj / BG_DN_PER_EXPERT, r = jj - e * BG_DN_PER_EXPERT, kb = r >> 6, nb = r & 63;
        dst = ws + WS_W_MDN + (size_t)e * 2048 * FE + (size_t)(nb * 32 + n) * FE + kb * 64 + 32 * kh; sc = 1.f / SWDN8; }
    else { const LAS float* s = (const LAS float*)scr + (32 * kh) * 32 + n;
        if (j < BG_J2) { const int r = j - BG_J1, kb = r / 352, nb = r - kb * 352; dst = ws + WS_W_GU + ((size_t)(nb * 32 + n) * 2048 + kb * 64 + 32 * kh) * 2; }
        else { const int r = j - BG_J2, kb = r >> 6, nb = r & 63; dst = ws + WS_W_DN + ((size_t)(nb * 32 + n) * FFN + kb * 64 + 32 * kh) * 2; }
#pragma unroll
        for (int h = 0; h < 4; ++h) { const f32x4 x0 = (f32x4){s[(8 * h + 0) * 32], s[(8 * h + 1) * 32], s[(8 * h + 2) * 32], s[(8 * h + 3) * 32]}, x1 = (f32x4){s[(8 * h + 4) * 32], s[(8 * h + 5) * 32], s[(8 * h + 6) * 32], s[(8 * h + 7) * 32]};
            *(u32x4*)(dst + 16 * h) = pack8(x0, x1); }
        return; }
    const LAS float* s = (const LAS float*)scr + (32 * kh) * 32 + n;
#pragma unroll
    for (int h = 0; h < 2; ++h) { u32x4 o;
        o.x = pack4_fp8_sc(s[(16 * h + 0) * 32], s[(16 * h + 1) * 32], s[(16 * h + 2) * 32], s[(16 * h + 3) * 32], sc);
        o.y = pack4_fp8_sc(s[(16 * h + 4) * 32], s[(16 * h + 5) * 32], s[(16 * h + 6) * 32], s[(16 * h + 7) * 32], sc);
        o.z = pack4_fp8_sc(s[(16 * h + 8) * 32], s[(16 * h + 9) * 32], s[(16 * h + 10) * 32], s[(16 * h + 11) * 32], sc);
        o.w = pack4_fp8_sc(s[(16 * h + 12) * 32], s[(16 * h + 13) * 32], s[(16 * h + 14) * 32], s[(16 * h + 15) * 32], sc);
        *(u32x4*)(dst + 16 * h) = o; }
}
__device__ __forceinline__ void sincos_d(double x, double& s, double& c) {
    const double kd = rint(x * 0.63661977236758134308); const double r = (x - kd * 1.57079632673412561417e+00) - kd * 6.07710050650619224932e-11; const double r2 = r * r;
    double sp = -7.6471637318198164759e-13; sp = sp * r2 + 1.6059043836821614599e-10; sp = sp * r2 - 2.5052108385441718775e-08; sp = sp * r2 + 2.7557319223985890653e-06;
    sp = sp * r2 - 1.9841269841269841270e-04; sp = sp * r2 + 8.3333333333333333333e-03; sp = sp * r2 - 1.6666666666666666667e-01; const double sr = r + r * r2 * sp;
    double cp = 4.7794773323873852974e-14; cp = cp * r2 - 1.1470745597729724714e-11; cp = cp * r2 + 2.0876756987868098979e-09; cp = cp * r2 - 2.7557319223985890653e-07;
    cp = cp * r2 + 2.4801587301587301587e-05; cp = cp * r2 - 1.3888888888888888889e-03; cp = cp * r2 + 4.1666666666666666667e-02; cp = cp * r2 - 0.5; const double cr = 1.0 + r2 * cp;
    const int q = ((int)kd) & 3;
    s = (q == 0) ? sr : (q == 1) ? cr : (q == 2) ? -sr : -cr; c = (q == 0) ? cr : (q == 1) ? -sr : (q == 2) ? -cr : sr;
}
constexpr int I0 = 32 * 68, I1 = I0 + 8 * 24, I2 = I1 + 8 * 32, I3 = I2 + 1024, I4 = I3 + 32 * 176, I5 = I4 + 88 * 32, I6 = I5 + 1024, I7 = I6 + 4 * 64, I8 = I7 + 1024,
              I9 = I8 + 8 * 32 * 224, I10 = I9 + 8 * 112 * 32;
#ifndef TAIL_ITEMS_1
#define TAIL_ITEMS_1 7992
#endif
#ifndef TAIL_ITEMS_2
#define TAIL_ITEMS_2 5000
#endif
constexpr int I_B = I10 - TAIL_ITEMS_2, I_A = I_B - TAIL_ITEMS_1;
static_assert((I_A - I9) % 64 == 0 && BG_DN_ITEMS == 2 * (I_A - I9), "the background down-weight items are exactly the prologue-form items [I9, I_A)");
__device__ __forceinline__ void convert_range(Frame& F, const Args& a, int begin, int end, int w, int nw) {
    LAS float* scr = (LAS float*)(F.lds + F.wave * 16896);
    unsigned char* ws = F.ws;
    auto decode = [&](int it, TD& d) {
        const float* W; const float* W2 = nullptr; const float* ksc = nullptr; const float* nsc = nullptr; bf16_t* WT; int K, Nsrc, Ndst, kind = TK_PLAIN, item;
        if (it < I0) { W = a.in[I_WIN]; K = 2048; Nsrc = 4168; Ndst = NIN; kind = TK_IN; WT = (bf16_t*)(ws + WS_W_IN); item = it; }
        else if (it < I1) { W = a.in[I_WUQ]; K = 512; Nsrc = 1536; Ndst = 1536; kind = TK_UQ; ksc = a.in[I_QNORM]; WT = (bf16_t*)(ws + WS_W_UP); item = it - I0; }
        else if (it < I2) { W = a.in[I_WUKV]; K = 512; Nsrc = 2048; Ndst = 2048; kind = TK_UKV; ksc = a.in[I_KVNORM]; WT = (bf16_t*)(ws + WS_W_UP) + (size_t)1536 * 512; item = it - I1; }
        else if (it < I3) { W = a.in[I_WOUT]; K = 2048; Nsrc = 2048; Ndst = 2048; WT = (bf16_t*)(ws + WS_W_OUT); item = it - I2; }
        else if (it < I4) { W = a.in[I_FGATE]; W2 = a.in[I_FUP]; K = 2048; Nsrc = FFN; Ndst = 2 * FFN; kind = TK_GU; WT = (bf16_t*)(ws + WS_W_GU); item = it - I3; }
        else if (it < I5) { W = a.in[I_FDOWN]; K = FFN; Nsrc = 2048; Ndst = 2048; WT = (bf16_t*)(ws + WS_W_DN); item = it - I4; }
        else if (it < I6) { W = a.in[I_PWIN]; K = 2048; Nsrc = 2048; Ndst = 2048; ksc = a.in[I_LNFG]; WT = (bf16_t*)(ws + WS_W_PIN); item = it - I5; }
        else if (it < I7) { const int r = it - I6, g = r >> 6; W = a.in[I_PWGRP] + (size_t)g * 512 * 512; K = 512; Nsrc = 512; Ndst = 512; nsc = a.in[I_PSCALE] + g * 512; WT = (bf16_t*)(ws + WS_W_GRP) + (size_t)g * 512 * 512; item = r & 63; }
        else if (it < I8) { W = a.in[I_PWOUT]; K = 2048; Nsrc = 2048; Ndst = 2048; WT = (bf16_t*)(ws + WS_W_POUT); item = it - I7; }
        else if (it < I9) { const int r = it - I8, e = r / (32 * 224); W = a.in[I_MGATE] + (size_t)e * 2048 * FE; W2 = a.in[I_MUP] + (size_t)e * 2048 * FE; K = 2048; Nsrc = FE; Ndst = 2 * FE; kind = TK_GU; WT = (bf16_t*)(ws + WS_W_MGU + (size_t)e * 2 * FE * 2048); item = r % (32 * 224); }
        else { const int r = it - I9, e = r / (112 * 32); W = a.in[I_MDOWN] + (size_t)e * FE * 2048; K = FE; Nsrc = 2048; Ndst = 2048; WT = (bf16_t*)(ws + WS_W_MDN + (size_t)e * 2048 * FE); item = r % (112 * 32); }
        const int f8 = it >= I8 ? 1 : 0; const int nblk = f8 ? Ndst / 32 : Ndst / 64;
        d.q8 = (it >= I3 && it < I4) ? 512.f : ((it >= I4 && it < I5) ? 2048.f : 0.f); d.fp8 = f8; d.wsc = it >= I9 ? SWDN8 : SWGU8; d.W = W; d.W2 = W2; d.ksc = ksc; d.nsc = nsc; d.WT = WT; d.K = K; d.Nsrc = Nsrc; d.kind = kind;
        d.k0 = f8 ? 128 * (item / nblk) : 64 * (item / nblk); d.n0 = f8 ? 32 * (item % nblk) : 64 * (item % nblk);
    };
    TD cur, nxt; f32x2 v[32]; int it = begin + w;
    if (it < end) { decode(it, cur); if (cur.fp8) t_load8(cur, F.lane, v); else t_load(cur, F.lane, v); }
    while (it < end) {
        if (cur.fp8) t_to_lds8(F.lane, v, scr); else t_to_lds(F.lane, v, scr);
        const int itn = it + nw;
        if (itn < end) { decode(itn, nxt); if (nxt.fp8) t_load8(nxt, F.lane, v); else t_load(nxt, F.lane, v); }
        LDS_WAIT(); asm volatile("" ::: "memory");
        if (cur.fp8) t_store8(cur, F.lane, scr); else t_store(cur, F.lane, scr);
        LDS_WAIT(); asm volatile("" ::: "memory");
        cur = nxt; it = itn;
    }
}
__device__ __forceinline__ void p0_prologue(Frame& F, const Args& a) {
    const int gw = F.vcu * 8 + F.wave, NGW = F.G * 8;
    unsigned char* ws = F.ws;
#if BG_IN_ATTN
    convert_range(F, a, 0, I3, gw, NGW);
    convert_range(F, a, I5, I8, gw, NGW);
    if (F.G != 256) convert_range(F, a, I_A, I10, gw, NGW);
#elif BG_IN_PROLOGUE
    convert_range(F, a, 0, I8, gw, NGW);
    convert_range(F, a, I9, F.G == 256 ? I_A : I10, gw, NGW);
    { LAS unsigned char* bscr = F.lds + F.wave * 16896;
      for (int j = gw; j < BG_GU_ITEMS; j += NGW) { bg_issue(a, j, bscr, F.lane); VM_WAIT(); asm volatile("" ::: "memory"); bg_flush(ws, j, bscr, F.lane); LDS_WAIT(); asm volatile("" ::: "memory"); } }
#else
    convert_range(F, a, 0, F.G == 256 ? I_A : I10, gw, NGW);
#endif
    { float* cs = (float*)(ws + WS_CS); const int gt = (F.vcu * 8 + F.wave) * 64 + F.lane, NT = F.G * 512;
      for (int i = gt; i < R * 32; i += NT) { const int row = i >> 5, j = i & 31; const int pos = row >= PADR ? row - PADR : 0;
          const float ang = (float)pos * INV_FREQ[j]; double s, c; sincos_d((double)ang, s, c); cs[(size_t)row * 64 + j] = (float)c; cs[(size_t)row * 64 + 32 + j] = (float)s; } }
    { bf16_t* hb = (bf16_t*)(ws + WS_L_H0B);
      for (int row = gw; row < R; row += NGW) { const float* src = row >= ROW0 ? a.in[I_X] + (size_t)(row - ROW0) * DM : (row >= PADR ? a.in[I_META] + (size_t)(row - PADR) * DM : nullptr);
#pragma unroll
          for (int j = 0; j < 4; ++j) { const int col = 8 * F.lane + 512 * j; f32x4 v0 = (f32x4){0.f, 0.f, 0.f, 0.f}, v1 = v0; if (src) { v0 = *(const f32x4*)(src + col); v1 = *(const f32x4*)(src + col + 4); }
              *(u32x4*)(hb + (size_t)row * DM + col) = pack8(v0, v1); } } }
}

__device__ __forceinline__ void p2_ext(Frame& F) {
    unsigned char* ws = F.ws; const float* lf = (const float*)(ws + WS_L_LF); const float* kr = (const float*)(ws + WS_L_KR); const float* cs = (const float*)(ws + WS_CS);
    bf16_t* qp = (bf16_t*)(ws + WS_L_QP); bf16_t* kp = (bf16_t*)(ws + WS_L_KP);
    LAS double* red = (LAS double*)(F.lds);
    const int CH = (LTOK + F.G - 1) / F.G;
    for (int ch = blockIdx.x; ch * CH < LTOK; ch += F.G) {
        const int p0 = ch * CH, p1 = (p0 + CH < LTOK) ? p0 + CH : LTOK;
        double accd[8];
#pragma unroll
        for (int h = 0; h < 8; ++h) accd[h] = 0.0;
        for (int p = F.tid; p < p0; p += 512) { const f32x4 a0 = *(const f32x4*)(lf + (size_t)(PADR + p) * 8), a1 = *(const f32x4*)(lf + (size_t)(PADR + p) * 8 + 4);
#pragma unroll
            for (int h = 0; h < 4; ++h) { accd[h] += (double)a0[h]; accd[4 + h] += (double)a1[h]; } }
#pragma unroll
        for (int h = 0; h < 8; ++h) { const double s = wave_sum_d(accd[h]); if (F.lane == 0) red[F.wave * 8 + h] = s; }
        __syncthreads();
        if (F.tid < 8) { double s = 0.0; for (int w = 0; w < 8; ++w) s += red[w * 8 + F.tid]; red[64 + F.tid] = s; }
        __syncthreads();
        const int nrow = p1 - p0;
        if (F.tid < nrow * 8) { const int r = F.tid >> 3, h = F.tid & 7; double c = red[64 + h];
            for (int i = 0; i <= r; ++i) c += (double)lf[(size_t)(PADR + p0 + i) * 8 + h];
            const float cf = (float)(c * 1.4426950408889634074);
            const float hi = bf2f(f2bf(cf)), r1 = cf - hi, mid = bf2f(f2bf(r1)), r2 = r1 - mid, lo = bf2f(f2bf(r2));
            const int pos = p0 + r, row = PADR + pos;
            u32x4 z = (u32x4){0u, 0u, 0u, 0u};
            u32x4 q0; q0.x = cvt_pk_bf16(hi, mid); q0.y = cvt_pk_bf16(lo, 1.f); q0.z = cvt_pk_bf16(1.f, 1.f); q0.w = 0u;
            u32x4 k0 = z; if (pos >= NMETA) { k0.x = cvt_pk_bf16(1.f, 1.f); k0.y = cvt_pk_bf16(1.f, -hi); k0.z = cvt_pk_bf16(-mid, -lo); }
            u32x4* qd = (u32x4*)(qp + ((size_t)(8 + h) * R + row) * DKP + 128); u32x4* kd = (u32x4*)(kp + ((size_t)(8 + h) * R + row) * DKP + 128);
            qd[0] = q0; kd[0] = k0;
#pragma unroll
            for (int j = 1; j < 8; ++j) { qd[j] = z; kd[j] = z; }
        }
        for (int i = F.tid; i < nrow * 32; i += 512) { const int r = i >> 5, j = i & 31, row = PADR + p0 + r;
            const float x1 = kr[(size_t)row * 64 + j], x2 = kr[(size_t)row * 64 + 32 + j], c = cs[(size_t)row * 64 + j], s = cs[(size_t)row * 64 + 32 + j];
            const bf16_t o1 = f2bf(x1 * c - x2 * s), o2 = f2bf(x2 * c + x1 * s);
#pragma unroll
            for (int h = 0; h < 8; ++h) { bf16_t* k = kp + ((size_t)h * R + row) * DKP + 128; k[j] = o1; k[32 + j] = o2; } }
        __syncthreads();
    }
}

__device__ __forceinline__ void p3_attn_naive(Frame& F) {
    unsigned char* ws = F.ws; const bf16_t* QP = (const bf16_t*)(ws + WS_L_QP); const bf16_t* KP = (const bf16_t*)(ws + WS_L_KP); const bf16_t* VP = (const bf16_t*)(ws + WS_L_VP);
    bf16_t* O = (bf16_t*)(ws + WS_L_O);
    LAS float* qs = (LAS float*)(F.lds + F.wave * 1024);
    const int gw = F.vcu * 8 + F.wave, NGW = F.G * 8, lane = F.lane;
    for (int t = gw; t < NH * LTOK; t += NGW) {
        const int head = t / LTOK, pos = t % LTOK, row = pos + PADR;
        const bf16_t* q = QP + ((size_t)head * R + row) * DKP;
        LDS_WAIT();
        for (int d = lane; d < DKP; d += 64) qs[d] = bf2f(q[d]);
        LDS_WAIT(); asm volatile("" ::: "memory");
        float mrun = -1e30f, l = 0.f, o0 = 0.f, o1 = 0.f; const int nk = pos + 1;
        for (int k0 = 0; k0 < nk; k0 += 64) {
            const int kpos = k0 + lane; float s = -__builtin_inff();
            if (kpos < nk) { const u32x4* kr = (const u32x4*)(KP + ((size_t)head * R + PADR + kpos) * DKP); float a = 0.f;
#pragma unroll 4
                for (int c = 0; c < 24; ++c) { const u32x4 kv = kr[c];
                    a += qs[c * 8 + 0] * bf_lo(kv.x) + qs[c * 8 + 1] * bf_hi(kv.x) + qs[c * 8 + 2] * bf_lo(kv.y) + qs[c * 8 + 3] * bf_hi(kv.y)
                       + qs[c * 8 + 4] * bf_lo(kv.z) + qs[c * 8 + 5] * bf_hi(kv.z) + qs[c * 8 + 6] * bf_lo(kv.w) + qs[c * 8 + 7] * bf_hi(kv.w); }
                s = a; }
            const float mn = fmaxf(mrun, wave_max(s)); const float alpha = __builtin_amdgcn_exp2f(mrun - mn); const float p = __builtin_amdgcn_exp2f(s - mn);
            l = l * alpha + wave_sum(p); o0 *= alpha; o1 *= alpha; mrun = mn;
            const int kn = (nk - k0) < 64 ? (nk - k0) : 64;
            for (int j = 0; j < kn; ++j) { const float pj = __shfl(p, j); const unsigned vv = *(const unsigned*)(VP + ((size_t)head * R + PADR + k0 + j) * DV + 2 * lane);
                o0 += pj * bf_lo(vv); o1 += pj * bf_hi(vv); }
        }
        const float il = 1.0f / l;
        *(unsigned*)(O + (size_t)row * DM + head * DV + 2 * lane) = cvt_pk_bf16(o0 * il, o1 * il);
    }
}


namespace att {
typedef float f32x16 __attribute__((ext_vector_type(16)));
typedef short s16x4 __attribute__((ext_vector_type(4)));
typedef LAS char* lptr; typedef const LAS char* lcptr;
constexpr int KVBLK = 64, KROW = 400, SHM_K = KVBLK * KROW, SHM_V = KVBLK * DV * 2;
constexpr int OFF_V = 0, OFF_K = 2 * SHM_V, OFF_WS = OFF_K + 2 * SHM_K, LDS_NEED = OFF_WS + 8 * 64 * 4;
constexpr float THR2 = 11.5f;
#define AT_KSWZ(row, colB) ((row) * KROW + (colB))
#define AT_SBAR() __builtin_amdgcn_sched_barrier(0)
__device__ __forceinline__ int v_st(int k, int c) { const int kk = (k & ~0xC) | ((k & 4) << 1) | ((k & 8) >> 1); return ((kk >> 3) * 4 + (c >> 5)) * 512 + ((kk & 7) * 32 + (c & 31)) * 2; }
__device__ __forceinline__ int v_rd_base(int lane) { return ((lane & 3) << 3) | (((lane >> 2) & 3) << 6) | (((lane >> 4) & 1) << 5) | (((lane >> 5) & 1) << 8); }
constexpr int v_rd_off(int d0, int ks, int half) { return d0 * 512 + ks * 4096 + half * 2048; }
__device__ __forceinline__ int crow(int r, int hi) { return (r & 3) + 8 * (r >> 2) + 4 * hi; }
__device__ __forceinline__ void mask_causal(f32x16& p0, f32x16& p1, int dq) {
    const float NEG = -__builtin_inff();
#pragma unroll
    for (int r = 0; r < 16; ++r) { const int c = (r & 3) + 8 * (r >> 2); if (dq - c < 0) p0[r] = NEG; if (dq - c - 32 < 0) p1[r] = NEG; }
}
__device__ __forceinline__ void mask_pad(f32x16& p0, f32x16& p1) {
    const float NEG = -__builtin_inff();
#pragma unroll
    for (int r = 0; r < 16; ++r) { p0[r] = NEG; if (r < 8) p1[r] = NEG; }
}
__device__ __forceinline__ void partialSM(f32x16& p0, f32x16& p1, float& m_reg, float& mn, float& alpha) {
    float pmax = p0[0];
#pragma unroll
    for (int r = 1; r < 16; ++r) pmax = fmaxf(pmax, p0[r]);
#pragma unroll
    for (int r = 0; r < 16; ++r) pmax = fmaxf(pmax, p1[r]);
    { auto rr = __builtin_amdgcn_permlane32_swap(__float_as_uint(pmax), __float_as_uint(pmax), false, false);
      pmax = fmaxf(__uint_as_float(rr[0]), __uint_as_float(rr[1])); }
    if (__builtin_expect(__all((pmax - m_reg) <= THR2), 1)) { mn = m_reg; alpha = 1.f; }
    else { mn = fmaxf(m_reg, pmax); alpha = __builtin_amdgcn_exp2f(m_reg - mn); m_reg = mn; }
#pragma unroll
    for (int r = 0; r < 16; ++r) p0[r] = __builtin_amdgcn_exp2f(p0[r] - mn);
}
__device__ __forceinline__ void finishSM(f32x16& p0, f32x16& p1, float mn, float alpha, float& l_reg, bf16x8& pa0, bf16x8& pa1, bf16x8& pa2, bf16x8& pa3) {
#pragma unroll
    for (int r = 0; r < 16; ++r) p1[r] = __builtin_amdgcn_exp2f(p1[r] - mn);
    float ps = 0;
#pragma unroll
    for (int r = 0; r < 16; ++r) ps += p0[r];
#pragma unroll
    for (int r = 0; r < 16; ++r) ps += p1[r];
    { auto rr = __builtin_amdgcn_permlane32_swap(__float_as_uint(ps), __float_as_uint(ps), false, false);
      ps = __uint_as_float(rr[0]) + __uint_as_float(rr[1]); }
    l_reg = l_reg * alpha + ps;
#define AT_PK4(P, B_, OUT) do { unsigned a0 = cvt_pk_bf16(P[B_+0], P[B_+1]), a1 = cvt_pk_bf16(P[B_+2], P[B_+3]);                          \
        unsigned b0 = cvt_pk_bf16(P[B_+4], P[B_+5]), b1 = cvt_pk_bf16(P[B_+6], P[B_+7]);                                             \
        auto r0 = __builtin_amdgcn_permlane32_swap(a0, b0, false, false); auto r1 = __builtin_amdgcn_permlane32_swap(a1, b1, false, false); \
        u32x4 w = {r0[0], r1[0], r0[1], r1[1]}; OUT = __builtin_bit_cast(bf16x8, w); } while (0)
    AT_PK4(p0, 0, pa0); AT_PK4(p0, 8, pa1); AT_PK4(p1, 0, pa2); AT_PK4(p1, 8, pa3);
#undef AT_PK4
}
#define AT_LGK(n) asm volatile("s_waitcnt lgkmcnt(" #n ")" ::: "memory")
__device__ __forceinline__ void qkt(f32x16& p0, f32x16& p1, lcptr kbuf, int r32, int hi, const bf16x8* qr) {
    p0 = f32x16{}; p1 = f32x16{};
    const unsigned kb = (unsigned)(size_t)kbuf + (unsigned)AT_KSWZ(r32, hi * 16);
    bf16x8 fa0, fa1, fb0, fb1, fc0, fc1;
#define QK_RD(dst, off) asm volatile("ds_read_b128 %0, %1 offset:%2" : "=&v"(dst) : "v"(kb), "i"(off) : "memory")
#define QK_LD(X, d0) do { QK_RD(X##0, 32 * (d0)); QK_RD(X##1, 32 * (d0) + 32 * KROW); } while (0)
#define QK_MM(X, d0) do { p0 = __builtin_amdgcn_mfma_f32_32x32x16_bf16(X##0, qr[d0], p0, 0, 0, 0); p1 = __builtin_amdgcn_mfma_f32_32x32x16_bf16(X##1, qr[d0], p1, 0, 0, 0); } while (0)
    QK_LD(fa, 0); QK_LD(fb, 1);
    QK_LD(fc, 2); AT_LGK(4); AT_SBAR(); QK_MM(fa, 0); AT_SBAR();
    QK_LD(fa, 3); AT_LGK(4); AT_SBAR(); QK_MM(fb, 1); AT_SBAR();
    QK_LD(fb, 4); AT_LGK(4); AT_SBAR(); QK_MM(fc, 2); AT_SBAR();
    QK_LD(fc, 5); AT_LGK(4); AT_SBAR(); QK_MM(fa, 3); AT_SBAR();
    QK_LD(fa, 6); AT_LGK(4); AT_SBAR(); QK_MM(fb, 4); AT_SBAR();
    QK_LD(fb, 7); AT_LGK(4); AT_SBAR(); QK_MM(fc, 5); AT_SBAR();
    QK_LD(fc, 8); AT_LGK(4); AT_SBAR(); QK_MM(fa, 6); AT_SBAR();
    QK_LD(fa, 9); AT_LGK(4); AT_SBAR(); QK_MM(fb, 7); AT_SBAR();
    QK_LD(fb, 10); AT_LGK(4); AT_SBAR(); QK_MM(fc, 8); AT_SBAR();
    QK_LD(fc, 11); AT_LGK(4); AT_SBAR(); QK_MM(fa, 9); AT_SBAR();
    AT_LGK(2); AT_SBAR(); QK_MM(fb, 10); AT_SBAR();
    AT_LGK(0); AT_SBAR(); QK_MM(fc, 11);
#undef QK_RD
#undef QK_LD
#undef QK_MM
}
template <int VB>
__device__ __forceinline__ void pv_tile(f32x16* o, unsigned vb0, bf16x8 pa0, bf16x8 pa1, bf16x8 pa2, bf16x8 pa3) {
    s16x4 al0, ah0, al1, ah1, al2, ah2, al3, ah3, bl0, bh0, bl1, bh1, bl2, bh2, bl3, bh3;
#define AT_TRRD(dst, off) asm volatile("ds_read_b64_tr_b16 %0, %1 offset:%2" : "=&v"(dst) : "v"(vb0), "i"(off) : "memory")
#define PV_RDA(S, d0) do { constexpr int b_ = VB * SHM_V + v_rd_off(d0, 0, 0); AT_TRRD(S##l0, b_); AT_TRRD(S##h0, b_ + 2048); AT_TRRD(S##l1, b_ + 4096); AT_TRRD(S##h1, b_ + 6144); } while (0)
#define PV_RDB(S, d0) do { constexpr int b_ = VB * SHM_V + v_rd_off(d0, 0, 0); AT_TRRD(S##l2, b_ + 8192); AT_TRRD(S##h2, b_ + 10240); AT_TRRD(S##l3, b_ + 12288); AT_TRRD(S##h3, b_ + 14336); } while (0)
#define PV_MM(d0, pa, L, H) do { AT_SBAR(); o[d0] = __builtin_amdgcn_mfma_f32_32x32x16_bf16(pa, (bf16x8){L[0], L[1], L[2], L[3], H[0], H[1], H[2], H[3]}, o[d0], 0, 0, 0); AT_SBAR(); } while (0)
    PV_RDA(a, 0); PV_RDB(a, 0);
    PV_RDA(b, 1); AT_LGK(10); PV_MM(0, pa0, al0, ah0); AT_LGK(8); PV_MM(0, pa1, al1, ah1);
    PV_RDB(b, 1); AT_LGK(10); PV_MM(0, pa2, al2, ah2); AT_LGK(8); PV_MM(0, pa3, al3, ah3);
    PV_RDA(a, 2); AT_LGK(10); PV_MM(1, pa0, bl0, bh0); AT_LGK(8); PV_MM(1, pa1, bl1, bh1);
    PV_RDB(a, 2); AT_LGK(10); PV_MM(1, pa2, bl2, bh2); AT_LGK(8); PV_MM(1, pa3, bl3, bh3);
    PV_RDA(b, 3); AT_LGK(10); PV_MM(2, pa0, al0, ah0); AT_LGK(8); PV_MM(2, pa1, al1, ah1);
    PV_RDB(b, 3); AT_LGK(10); PV_MM(2, pa2, al2, ah2); AT_LGK(8); PV_MM(2, pa3, al3, ah3);
    AT_LGK(6); PV_MM(3, pa0, bl0, bh0); AT_LGK(4); PV_MM(3, pa1, bl1, bh1); AT_LGK(2); PV_MM(3, pa2, bl2, bh2); AT_LGK(0); PV_MM(3, pa3, bl3, bh3);
#undef PV_RDA
#undef PV_RDB
#undef PV_MM
#undef AT_TRRD
}
__device__ __forceinline__ void attn_block(const bf16_t* Qh, const bf16_t* Kh, const bf16_t* Vh, bf16_t* Oh, int b, bool rev, lptr lds, const Args& bga, unsigned char* bgws, int& bgt, int& bgk, int& bgp, int bgw, int bgn) {
    const int tid = threadIdx.x, wid = __builtin_amdgcn_readfirstlane(tid >> 6), lane = tid & 63, r32 = lane & 31, hi = lane >> 5;
    const int j_lo = 3, NT = 4 * b + 1;
    lptr V_lds = lds + OFF_V; lptr K_lds = lds + OFF_K;
    LAS float* wsf = (LAS float*)(lds + OFF_WS) + wid * 64; LAS float* li_l = wsf; LAS float* al_l = wsf + 32;
    LAS unsigned char* bscr = (LAS unsigned char*)(lds + LDS_NEED) + wid * 8192;
    const int qlo = 256 * b + wid * 32, qrow = qlo + r32;
    unsigned koff[3], voff[2];
#pragma unroll
    for (int i = 0; i < 3; ++i) { const int g = (wid + 8 * i) * 64 + lane, row = g / 25, cp = g - row * 25; koff[i] = (unsigned)(row * 384 + (cp < 24 ? cp : 0) * 16); }
    unsigned koff3; { const int g = 24 * 64 + lane, row = g / 25, cp = g - row * 25; koff3 = (unsigned)(row * 384 + (cp < 24 ? cp : 0) * 16); }
#pragma unroll
    for (int i = 0; i < 2; ++i) { const int byte = ((wid + 8 * i) * 64 + lane) * 16, sub = byte >> 9, el = (byte & 511) >> 1, kk = (sub >> 2) * 8 + (el >> 5), c = (sub & 3) * 32 + (el & 31);
        const int k = (kk & ~0xC) | ((kk & 4) << 1) | ((kk & 8) >> 1); voff[i] = (unsigned)(k * 256 + c * 2); }
    const unsigned vb0 = (unsigned)(size_t)V_lds + (unsigned)v_rd_base(lane);
    bf16x8 qr[12];
#pragma unroll
    for (int d0 = 0; d0 < 12; ++d0) qr[d0] = *(const bf16x8*)(Qh + (size_t)qrow * DKP + d0 * 16 + hi * 8);
#define AT_JJ(t) (rev ? j_lo + NT - 1 - (t) : j_lo + (t))
#define AT_SLOAD(t, bf) do { const char* kt = (const char*)(Kh + (size_t)AT_JJ(t) * KVBLK * DKP); const char* vt = (const char*)(Vh + (size_t)AT_JJ(t) * KVBLK * DV); \
        _Pragma("unroll") for (int i_ = 0; i_ < 3; ++i_) __builtin_amdgcn_global_load_lds((const unsigned*)(kt + koff[i_]), (LAS unsigned*)(K_lds + (bf) * SHM_K + (wid + 8 * i_) * 1024), 16, 0, 0); \
        if (wid == 0) __builtin_amdgcn_global_load_lds((const unsigned*)(kt + koff3), (LAS unsigned*)(K_lds + (bf) * SHM_K + 24 * 1024), 16, 0, 0); \
        _Pragma("unroll") for (int i_ = 0; i_ < 2; ++i_) __builtin_amdgcn_global_load_lds((const unsigned*)(vt + voff[i_]), (LAS unsigned*)(V_lds + (bf) * SHM_V + (wid + 8 * i_) * 1024), 16, 0, 0); } while (0)
    AT_SLOAD(0, 0); VM_WAIT();
    __syncthreads();
    float m_reg = -1e30f, l_reg = 0.f; f32x16 o[4] = {};
    f32x16 p0, p1; float mn, alpha; bf16x8 pa0, pa1, pa2, pa3;
#define AT_TILE(t, BUF) do { \
        if ((t) + 1 < NT) AT_SLOAD((t) + 1, (BUF) ^ 1); \
        AT_SBAR(); qkt(p0, p1, K_lds + (BUF) * SHM_K, r32, hi, qr); AT_SBAR(); \
        bool bgi_ = false; \
        if (BG_IN_ATTN) { if (bgp >= 0) { if ((t) + 1 < NT) asm volatile("s_waitcnt vmcnt(5)" ::: "memory"); else VM_WAIT(); bg_flush(bgws, bgp, bscr, lane); bgp = -1; LDS_WAIT(); } \
            if ((unsigned)(bgt + wid) % 5u < 3u) { const int bj_ = bgk * bgn + bgw; if (bj_ < BG_ITEMS) { bg_issue(bga, bj_, bscr, lane); bgp = bj_; ++bgk; bgi_ = true; } } ++bgt; } AT_SBAR(); \
        { const int jj_ = AT_JJ(t), kb_ = jj_ * KVBLK; if (jj_ == j_lo) mask_pad(p0, p1); if (kb_ + KVBLK - 1 > qlo) mask_causal(p0, p1, qrow - kb_ - 4 * hi); } \
        partialSM(p0, p1, m_reg, mn, alpha); \
        if (__any(alpha < 1.f)) { if (hi == 0) al_l[r32] = alpha; LDS_WAIT(); \
            _Pragma("unroll") for (int d_ = 0; d_ < 4; ++d_) _Pragma("unroll") for (int r = 0; r < 16; ++r) o[d_][r] *= al_l[crow(r, hi)]; } \
        finishSM(p0, p1, mn, alpha, l_reg, pa0, pa1, pa2, pa3); AT_SBAR(); \
        pv_tile<BUF>(o, vb0, pa0, pa1, pa2, pa3); \
        if (bgi_) asm volatile("s_waitcnt vmcnt(8)" ::: "memory"); else VM_WAIT(); LDS_WAIT(); __builtin_amdgcn_s_barrier(); } while (0)
    for (int t = 0; t < NT; t += 2) { AT_TILE(t, 0); if (t + 1 < NT) AT_TILE(t + 1, 1); }
    if (hi == 0) li_l[r32] = l_reg; LDS_WAIT();
    float rli[16];
#pragma unroll
    for (int r = 0; r < 16; ++r) { const float lv = li_l[crow(r, hi)]; rli[r] = lv > 0.f ? __builtin_amdgcn_rcpf(lv) : 0.f; }
    bf16_t* Ow = Oh + (size_t)qlo * DM;
#pragma unroll
    for (int r = 0; r < 16; ++r) { const int orow = crow(r, hi);
#pragma unroll
        for (int d0 = 0; d0 < 4; ++d0) { const float v = o[d0][r] * rli[r]; const float vn = __shfl_xor(v, 1);
            if ((r32 & 1) == 0) *(unsigned*)(Ow + (size_t)orow * DM + d0 * 32 + r32) = cvt_pk_bf16(v, vn); } }
    __syncthreads();
#undef AT_SLOAD
#undef AT_JJ
#undef AT_TILE
}
}
__device__ __forceinline__ void p3_attn(Frame& F, const Args& a) {
    unsigned char* ws = F.ws; const bf16_t* QP = (const bf16_t*)(ws + WS_L_QP); const bf16_t* KP = (const bf16_t*)(ws + WS_L_KP); const bf16_t* VP = (const bf16_t*)(ws + WS_L_VP);
    bf16_t* O = (bf16_t*)(ws + WS_L_O);
    att::lptr lds = (att::lptr)F.lds;
    int bgt = 0, bgk = 0, bgp = -1; const int bgw = F.vcu * 8 + F.wave, bgn = F.G * 8;
    for (int L = F.vcu; L < NH * 16; L += F.G) {
        const int nseq = L < NH ? 3 : 2;
        for (int sq = 0; sq < nseq; ++sq) {
            const int head = sq < 2 ? (L >> 4) : L, x = L & 15, b = sq == 0 ? 32 - x : (sq == 1 ? x + 1 : 0);
            att::attn_block(QP + (size_t)head * R * DKP, KP + (size_t)head * R * DKP, VP + (size_t)head * R * DV, O + head * DV, b, sq == 1, lds, a, ws, bgt, bgk, bgp, bgw, bgn);
        }
    }
    if (BG_IN_ATTN) {
        LAS unsigned char* bscr = (LAS unsigned char*)(F.lds + att::LDS_NEED) + F.wave * 8192;
        VM_WAIT(); asm volatile("" ::: "memory");
        if (bgp >= 0) { bg_flush(ws, bgp, bscr, F.lane); LDS_WAIT(); asm volatile("" ::: "memory"); }
        for (int j = bgk * bgn + bgw; j < BG_ITEMS; j += bgn) { bg_issue(a, j, bscr, F.lane); VM_WAIT(); asm volatile("" ::: "memory"); bg_flush(ws, j, bscr, F.lane); LDS_WAIT(); asm volatile("" ::: "memory"); }
    }
}

__device__ __forceinline__ void ln_core(f32x4 (&v)[8], const float* g, const float* b, int lane, float* mean_out = nullptr, float* rstd_out = nullptr) {
    float s = 0.f;
#pragma unroll
    for (int j = 0; j < 8; ++j) s += (v[j][0] + v[j][1]) + (v[j][2] + v[j][3]);
    const float mean = wave_sum(s) * (1.f / DM); float s2 = 0.f;
#pragma unroll
    for (int j = 0; j < 8; ++j) { v[j] = v[j] - mean; s2 += (v[j][0] * v[j][0] + v[j][1] * v[j][1]) + (v[j][2] * v[j][2] + v[j][3] * v[j][3]); }
    const float rstd = 1.f / sqrtf(wave_sum(s2) * (1.f / DM) + LN_EPS);
    if (mean_out) { *mean_out = mean; *rstd_out = rstd; }
#pragma unroll
    for (int j = 0; j < 8; ++j) { const f32x4 gg = *(const f32x4*)(g + 4 * lane + 256 * j), bb = *(const f32x4*)(b + 4 * lane + 256 * j); v[j] = v[j] * rstd * gg + bb; }
}
__device__ __forceinline__ void ln_phase(Frame& F, const float* Y, const float* g, const float* b, float* stats, bf16_t* HB, bool emu = false) {
    const int gw = F.vcu * 8 + F.wave, NGW = F.G * 8;
    f32x4 v[8], vn[8]; int row = PADR + gw;
    if (row < R) {
#pragma unroll
        for (int j = 0; j < 8; ++j) v[j] = *(const f32x4*)(Y + (size_t)row * DM + 4 * F.lane + 256 * j); }
    for (; row < R; row += NGW) {
        const int rn = row + NGW;
        if (rn < R) {
#pragma unroll
            for (int j = 0; j < 8; ++j) vn[j] = *(const f32x4*)(Y + (size_t)rn * DM + 4 * F.lane + 256 * j); }
        float mean, rstd; ln_core(v, g, b, F.lane, &mean, &rstd);
        if (F.lane == 0) *(f32x2*)(stats + (size_t)row * 2) = (f32x2){mean, rstd};
#pragma unroll
        for (int j = 0; j < 8; ++j) *(u32x2*)(HB + (size_t)row * DM + 4 * F.lane + 256 * j) = pack4((FP8_EMU && emu) ? q8v(v[j], 16.f) : v[j]);
#pragma unroll
        for (int j = 0; j < 8; ++j) v[j] = vn[j];
    }
}

template <int MODE>
__device__ __forceinline__ void skinny_meta(Frame& F, const bf16_t* A, int lda, const bf16_t* Bt, int K, float* out, const float* res, const float* g = nullptr, const float* b = nullptr) {
    LAS float* red = (LAS float*)F.lds;
    const int lane = F.lane, i16 = lane & 15, kq = lane >> 4, kc = K / 8;
    for (int ng = F.vcu; ng < DM / 16; ng += F.G) {
        const bf16_t* ap = A + (size_t)(PADR + i16) * lda + F.wave * kc + 8 * kq; const bf16_t* bp = Bt + (size_t)(ng * 16 + i16) * K + F.wave * kc + 8 * kq;
        f32x4 acc = (f32x4){0.f, 0.f, 0.f, 0.f};
#pragma unroll 8
        for (int k0 = 0; k0 < kc; k0 += 32) acc = __builtin_amdgcn_mfma_f32_16x16x32_bf16(*(const bf16x8*)(ap + k0), *(const bf16x8*)(bp + k0), acc, 0, 0, 0);
        *(LAS f32x4*)(red + (F.wave * 64 + lane) * 4) = acc;
        __syncthreads();
        if (F.tid < 256) { const int e = F.tid & 63, r = F.tid >> 6; float sum = 0.f;
#pragma unroll
            for (int w = 0; w < 8; ++w) sum += red[(w * 64 + e) * 4 + r];
            const int row = PADR + 4 * (e >> 4) + r, col = ng * 16 + (e & 15);
            if (MODE == 0) sum += ALPHA * res[(size_t)(row - PADR) * DM + col]; else if (MODE == 1) { const float mean = res[(size_t)row * 2], rstd = res[(size_t)row * 2 + 1]; sum += ALPHA * ((out[(size_t)row * DM + col] - mean) * rstd * g[col] + b[col]); }
            if (MODE == 2) ((bf16_t*)out)[(size_t)row * DM + col] = f2bf(sum); else out[(size_t)row * DM + col] = sum; }
        __syncthreads();
    }
}


__device__ __forceinline__ void calc_c12(Frame& F, const bf16_t* WT, int N, const float* g, const float* b, float* c1, float* c2, int gw, int NGW) {
    const int lane = F.lane;
    for (int n = gw; n < N; n += NGW) { float s1 = 0.f, s2 = 0.f;
#pragma unroll
        for (int j = 0; j < 4; ++j) { const int k = 8 * lane + 512 * j; const u32x4 w = *(const u32x4*)(WT + (size_t)n * DM + k);
            const f32x4 g0 = *(const f32x4*)(g + k), g1 = *(const f32x4*)(g + k + 4), b0 = *(const f32x4*)(b + k), b1 = *(const f32x4*)(b + k + 4);
            const f32x4 w0 = (f32x4){bf_lo(w.x), bf_hi(w.x), bf_lo(w.y), bf_hi(w.y)}, w1 = (f32x4){bf_lo(w.z), bf_hi(w.z), bf_lo(w.w), bf_hi(w.w)};
            const f32x4 q0 = w0 * b0 / g0, q1 = w1 * b1 / g1;
            s1 += ((w0[0] + w0[1]) + (w0[2] + w0[3])) + ((w1[0] + w1[1]) + (w1[2] + w1[3])); s2 += ((q0[0] + q0[1]) + (q0[2] + q0[3])) + ((q1[0] + q1[1]) + (q1[2] + q1[3])); }
        s1 = wave_sum(s1); s2 = wave_sum(s2);
        if (lane == 0) { c1[n] = s1; c2[n] = s2; } }
}
__device__ __forceinline__ void meta_stats(Frame& F, const float* Y, volatile LAS float* ms) {
    f32x4 v[2][8];
#pragma unroll
    for (int q = 0; q < 2; ++q)
#pragma unroll
        for (int j = 0; j < 8; ++j) v[q][j] = *(const f32x4*)(Y + (size_t)(PADR + F.wave + 8 * q) * DM + 4 * F.lane + 256 * j);
    __builtin_amdgcn_sched_barrier(0);
#pragma unroll
    for (int q = 0; q < 2; ++q) { const int i = F.wave + 8 * q; float s = 0.f;
#pragma unroll
        for (int j = 0; j < 8; ++j) s += (v[q][j][0] + v[q][j][1]) + (v[q][j][2] + v[q][j][3]);
        const float mean = wave_sum(s) * (1.f / DM); float s2 = 0.f;
#pragma unroll
        for (int j = 0; j < 8; ++j) { const f32x4 d = v[q][j] - mean; s2 += (d[0] * d[0] + d[1] * d[1]) + (d[2] * d[2] + d[3] * d[3]); }
        const float rstd = 1.f / sqrtf(wave_sum(s2) * (1.f / DM) + LN_EPS);
        if (F.lane == 0) { ms[2 * i] = mean; ms[2 * i + 1] = rstd; } }
    __syncthreads();
}
__device__ __forceinline__ void skinny_meta_ln(Frame& F, const float* Y, const volatile LAS float* ms, const bf16_t* Bt, const float* c2, bf16_t* out) {
    LAS float* red = (LAS float*)F.lds;
    const int lane = F.lane, i16 = lane & 15, kq = lane >> 4, kc = DM / 8; const float mean = ms[2 * i16], rstd = ms[2 * i16 + 1];
    for (int ng = F.vcu; ng < DM / 16; ng += F.G) {
        const float* ap = Y + (size_t)(PADR + i16) * DM + F.wave * kc + 8 * kq; const bf16_t* bp = Bt + (size_t)(ng * 16 + i16) * DM + F.wave * kc + 8 * kq;
        f32x4 acc = (f32x4){0.f, 0.f, 0.f, 0.f};
#pragma unroll 8
        for (int k0 = 0; k0 < kc; k0 += 32) { const f32x4 a0 = (*(const f32x4*)(ap + k0) - mean) * rstd, a1 = (*(const f32x4*)(ap + k0 + 4) - mean) * rstd;
            acc = __builtin_amdgcn_mfma_f32_16x16x32_bf16(__builtin_bit_cast(bf16x8, pack8(a0, a1)), *(const bf16x8*)(bp + k0), acc, 0, 0, 0); }
        *(LAS f32x4*)(red + (F.wave * 64 + lane) * 4) = acc;
        __syncthreads();
        if (F.tid < 256) { const int e = F.tid & 63, r = F.tid >> 6; float sum = 0.f;
#pragma unroll
            for (int w = 0; w < 8; ++w) sum += red[(w * 64 + e) * 4 + r];
            const int row = PADR + 4 * (e >> 4) + r, col = ng * 16 + (e & 15);
            out[(size_t)row * DM + col] = f2bf(sum + c2[col]); }
        __syncthreads();
    }
}

__device__ __forceinline__ f32x4 ld4bf(const bf16_t* p) { const u32x2 w = *(const u32x2*)p; return (f32x4){bf_lo(w.x), bf_hi(w.x), bf_lo(w.y), bf_hi(w.y)}; }
template <int W> __device__ __forceinline__ void pool_run(const bf16_t* HP, bf16_t* PB, int row0, int t) {
    f32x4 x[32], h[W - 1];
#pragma unroll
    for (int i = 0; i < W - 1; ++i) h[i] = ld4bf(HP + (size_t)(row0 - (W - 1) + i) * DM + 4 * t);
#pragma unroll
    for (int rr = 0; rr < 32; ++rr) x[rr] = ld4bf(HP + (size_t)(row0 + rr) * DM + 4 * t);
    f32x4 s = (f32x4){0.f, 0.f, 0.f, 0.f};
#pragma unroll
    for (int i = 0; i < W - 1; ++i) s += h[i];
    constexpr float iw = 1.0f / (float)W;
#pragma unroll
    for (int rr = 0; rr < 32; ++rr) { s += x[rr]; *(u32x2*)(PB + (size_t)(row0 + rr) * DM + 4 * t) = pack4(s * iw - x[rr]);
        const int old = rr - (W - 1); s -= old >= 0 ? x[old >= 0 ? old : 0] : h[old >= 0 ? 0 : old + (W - 1)]; }
}
__device__ __forceinline__ void p10_pool(Frame& F) {
    const bf16_t* HP = (const bf16_t*)(F.ws + WS_L_HP); bf16_t* PB = (bf16_t*)(F.ws + WS_L_PB);
    const int t = F.tid, g = F.wave >> 1;
    for (int run = blockIdx.x; run < SEQ / 32; run += F.G) { const int row0 = ROW0 + 32 * run;
        if (g == 0) pool_run<2>(HP, PB, row0, t); else if (g == 1) pool_run<4>(HP, PB, row0, t); else if (g == 2) pool_run<8>(HP, PB, row0, t); else pool_run<16>(HP, PB, row0, t); }
}

__device__ __forceinline__ void p13_ln_route(Frame& F, const Args& a) {
    unsigned char* ws = F.ws; const float* Y = (const float*)(ws + WS_Y); unsigned char* XG = ws + WS_M_XG;
    int* rinfo = (int*)(ws + WS_RINFO); float* tokg = (float*)(ws + WS_TOKG); int* tokep = (int*)(ws + WS_TOKG + 65536);
    LAS float* wr_l = (LAS float*)F.lds;
    for (int i = F.tid; i < DM * 8 / 4; i += 512) { const int c = i >> 1; *(LAS f32x4*)(wr_l + c * 8 + (c >> 2) * 4 + (i & 1) * 4) = ((const f32x4*)a.in[I_MROUTER])[i]; }
    __syncthreads();
    const float* g = a.in[I_LNMG] + DM; const float* b = a.in[I_LNMB] + DM;
    const int gw = F.vcu * 8 + F.wave, NGW = F.G * 8, lane = F.lane;
    for (int tok = gw; tok < SEQ; tok += NGW) { const int row = ROW0 + tok; f32x4 v[8];
#pragma unroll
        for (int j = 0; j < 8; ++j) v[j] = *(const f32x4*)(Y + (size_t)row * DM + 4 * lane + 256 * j);
        ln_core(v, g, b, lane);
        float lg[8];
#pragma unroll
        for (int e = 0; e < 8; ++e) lg[e] = 0.f;
        const LAS float* wl = wr_l + lane * 36;
#pragma unroll
        for (int j = 0; j < 8; ++j) {
#pragma unroll
            for (int i = 0; i < 4; ++i) { const f32x4 w0 = *(const LAS f32x4*)(wl + j * 2304 + i * 8), w1 = *(const LAS f32x4*)(wl + j * 2304 + i * 8 + 4); const float x = v[j][i];
                lg[0] += x * w0[0]; lg[1] += x * w0[1]; lg[2] += x * w0[2]; lg[3] += x * w0[3]; lg[4] += x * w1[0]; lg[5] += x * w1[1]; lg[6] += x * w1[2]; lg[7] += x * w1[3]; }
            __builtin_amdgcn_sched_barrier(0); }
#pragma unroll
        for (int e = 0; e < 8; ++e) lg[e] = wave_sum(lg[e]) + a.in[I_MBROUTER][e];
        int e0 = 0; float v0 = lg[0];
#pragma unroll
        for (int e = 1; e < 8; ++e) if (lg[e] > v0) { v0 = lg[e]; e0 = e; }
        int e1 = -1; float v1 = -__builtin_inff();
#pragma unroll
        for (int e = 0; e < 8; ++e) if (e != e0 && lg[e] > v1) { v1 = lg[e]; e1 = e; }
        const float g1 = 1.0f / (1.0f + expf(v0 - v1)), g0 = 1.0f - g1;
        int p0 = 0, p1 = 0;
        if (lane == 0) { p0 = (int)atomicAdd(F.ctl + CW_CNT + 64 * e0, 1u); p1 = (int)atomicAdd(F.ctl + CW_CNT + 64 * e1, 1u);
            rinfo[e0 * CAP + p0] = tok * 2; rinfo[e1 * CAP + p1] = tok * 2 + 1; tokg[tok * 2] = g0; tokg[tok * 2 + 1] = g1; tokep[tok * 2] = e0 * CAP + p0; tokep[tok * 2 + 1] = e1 * CAP + p1; }
        p0 = __shfl(p0, 0); p1 = __shfl(p1, 0);
        unsigned char* x0 = XG + ((size_t)e0 * CAP + p0) * DM; unsigned char* x1 = XG + ((size_t)e1 * CAP + p1) * DM;
#pragma unroll
        for (int j = 0; j < 8; ++j) { const unsigned pk = pack4_fp8_sc(v[j][0], v[j][1], v[j][2], v[j][3], 1.0f / SX8);
            *(unsigned*)(x0 + 4 * lane + 256 * j) = pk; *(unsigned*)(x1 + 4 * lane + 256 * j) = pk; } }
}
__device__ __forceinline__ void moe_tables(Frame& F, int nNx) {
    __syncthreads();
    if (F.tid == 0) { int pu = 0, seg = 0; int cnt[8];
#pragma unroll
        for (int e = 0; e < 8; ++e) cnt[e] = (int)__hip_atomic_load(F.ctl + CW_CNT + 64 * e, __ATOMIC_RELAXED, __HIP_MEMORY_SCOPE_AGENT);
#pragma unroll
        for (int e = 0; e < 8; ++e) { const int c = cnt[e]; const int nt = (c + 255) >> 8;
            F.MISC[e] = c; F.MISC[8 + e] = nt; F.MISC[16 + e] = pu; F.MISC[32 + e] = seg; pu += nt * nNx; seg += nt * 256; }
        F.MISC[24] = pu; }
    __syncthreads();
}
__device__ __forceinline__ void moe_tables_down(Frame& F) {
    __syncthreads();
    if (F.tid == 0) { int tp = 0, puA = 0, puB = 0, ovf = 0; int cnt[8];
#pragma unroll
        for (int e = 0; e < 8; ++e) cnt[e] = (int)__hip_atomic_load(F.ctl + CW_CNT + 64 * e, __ATOMIC_RELAXED, __HIP_MEMORY_SCOPE_AGENT);
#pragma unroll
        for (int e = 0; e < 8; ++e) { const int c = cnt[e]; const int nt = (c + 255) >> 8;
            int nA = FULL_TILES - tp; nA = nA < 0 ? 0 : (nA > nt ? nt : nA); const int nB = nt - nA;
            F.MISC[e] = c; F.MISC[8 + e] = nA; F.MISC[16 + e] = puA; F.MISC[32 + e] = tp * 256; F.MISC[40 + e] = 0; F.MISC[48 + e] = 0;
            F.MISC[128 + e] = c; F.MISC[136 + e] = nB; F.MISC[144 + e] = puB; F.MISC[160 + e] = tp * 256; F.MISC[168 + e] = nA; F.MISC[176 + e] = ovf;
            puA += nA * 8; puB += nB * 8 * KSB; ovf += nB; tp += nt; }
        F.MISC[24] = puA; F.MISC[152] = puB; }
    __syncthreads();
}
__device__ __forceinline__ void p16_final(Frame& F, const Args& a) {
    unsigned char* ws = F.ws; const float* Y = (const float*)(ws + WS_Y); const bf16_t* YM = (const bf16_t*)(ws + WS_M_XG); const bf16_t* YX = (const bf16_t*)(ws + WS_M_XG + 64 * MiB);
    const float* tokg = (const float*)(ws + WS_TOKG); const int* tokep = (const int*)(ws + WS_TOKG + 65536);
    const float* g = a.in[I_LNFG] + DM; const float* b = a.in[I_LNFB] + DM; const float* g3 = a.in[I_LNMG] + DM; const float* b3 = a.in[I_LNMB] + DM;
    const int gw = F.vcu * 8 + F.wave, NGW = F.G * 8;
    __syncthreads();
    if (F.tid == 0) { int tp = 0; int cnt[8];
#pragma unroll
        for (int e = 0; e < 8; ++e) cnt[e] = (int)__hip_atomic_load(F.ctl + CW_CNT + 64 * e, __ATOMIC_RELAXED, __HIP_MEMORY_SCOPE_AGENT);
#pragma unroll
        for (int e = 0; e < 8; ++e) { F.MISC[200 + e] = tp; tp += (cnt[e] + 255) >> 8; } }
    __syncthreads();
    const int lane0 = F.lane;
    for (int tok = gw; tok < SEQ; tok += NGW) { const int row = ROW0 + tok; f32x4 v[8]; const float g0 = tokg[tok * 2], g1 = tokg[tok * 2 + 1];
        int lane = lane0; asm volatile("" : "+v"(lane));
        int sr0 = -1, sr1 = -1;
        { const int ep = __builtin_amdgcn_readfirstlane(tokep[tok * 2]), e = ep >> 13, p = ep & (CAP - 1), gid = F.MISC[200 + e] + (p >> 8); if (gid >= FULL_TILES) sr0 = (gid - FULL_TILES) * 256 + (p & 255); }
        { const int ep = __builtin_amdgcn_readfirstlane(tokep[tok * 2 + 1]), e = ep >> 13, p = ep & (CAP - 1), gid = F.MISC[200 + e] + (p >> 8); if (gid >= FULL_TILES) sr1 = (gid - FULL_TILES) * 256 + (p & 255); }
        sr0 = __builtin_amdgcn_readfirstlane(sr0); sr1 = __builtin_amdgcn_readfirstlane(sr1);
#pragma unroll
        for (int j = 0; j < 8; ++j) v[j] = *(const f32x4*)(Y + (size_t)row * DM + 4 * lane + 256 * j);
        ln_core(v, g3, b3, lane);
#pragma unroll
        for (int j = 0; j < 8; ++j) { const int col = 4 * lane + 256 * j;
            f32x4 y0 = ld4bf(YM + ((size_t)0 * SEQ + tok) * DM + col), y1 = ld4bf(YM + ((size_t)1 * SEQ + tok) * DM + col);
            if (sr0 >= 0) {
#pragma unroll
                for (int q = 0; q < KSB - 1; ++q) y0 += ld4bf(YX + ((size_t)q * OVF_ROWS + sr0) * DM + col); }
            if (sr1 >= 0) {
#pragma unroll
                for (int q = 0; q < KSB - 1; ++q) y1 += ld4bf(YX + ((size_t)q * OVF_ROWS + sr1) * DM + col); }
            v[j] = v[j] * ALPHA + y0 * g0 + y1 * g1; if (j & 1) __builtin_amdgcn_sched_barrier(0); }
        ln_core(v, g, b, lane);
#pragma unroll
        for (int j = 0; j < 8; ++j) *(f32x4*)(a.out + (size_t)tok * DM + 4 * lane + 256 * j) = v[j]; }
}

__global__ void __launch_bounds__(512, 2) fwd(Args args) {
    extern __shared__ __attribute__((aligned(16))) unsigned char lds[];
    Frame F;
    F.lds = (LAS unsigned char*)lds; F.MISC = (volatile LAS int*)(F.lds + MISC_OFF);
    F.tid = threadIdx.x; F.lane = F.tid & 63; F.wave = __builtin_amdgcn_readfirstlane(F.tid >> 6);
    F.G = gridDim.x; { const int bx = blockIdx.x; F.vcu = (F.G % 8 == 0) ? (bx % 8) * (F.G / 8) + bx / 8 : bx; }
    F.ws = args.ws; F.ctl = (unsigned*)(args.ws + WS_CTL);
    unsigned char* ws = args.ws;
    for (int u = F.tid; u < 256; u += 512) F.MISC[u] = 0;
    __syncthreads();
#if MK_ONE_LAUNCH
    XcdBarrier bar = xcd_barrier_post(F.ctl + CW_BAR, (volatile LAS unsigned*)(F.MISC + 64));
#define GRID_BAR() xcd_barrier(bar)
#else
#define GRID_BAR() do { } while (0)
#endif
    const int lo = args.ph_lo, hi = args.ph_hi;
#define IN(k) (lo <= (k) && (k) < hi)
#define SEAM(k) do { if (IN(k) && IN((k) + 1)) GRID_BAR(); } while (0)
#define REP(k) _Pragma("unroll") for (int rep_ = 0; rep_ < ((((DUP_MASK) >> (k)) & 1u) ? 2 : 1); ++rep_)
    LAS unsigned char* ring = F.lds;
    const int bx = (int)blockIdx.x;

    if (IN(0)) REP(0) { p0_prologue(F, args); SEAM(0); }
    if (IN(1)) REP(1) {
        pg8::DenseSched<0> S{NPAN, NIN / 256, F.G, bx, 0, (const char*)(ws + WS_L_H0B), (const char*)(ws + WS_W_IN), (size_t)256 * DM * 2, (size_t)256 * DM * 2};
        pg8::EpiIn E{ws, args.in[I_FBIAS]};
        if (F.G != 256) calc_c12(F, (const bf16_t*)(ws + WS_W_PIN), DM, args.in[I_LNFG], args.in[I_LNFB], (float*)(ws + WS_C12), (float*)(ws + WS_C12) + DM, F.vcu * 8 + F.wave, F.G * 8);
        pg8::gemm_phase(ring, DM, DM, DM, S, E);
        if (F.G == 256 && bx >= 49) { calc_c12(F, (const bf16_t*)(ws + WS_W_PIN), DM, args.in[I_LNFG], args.in[I_LNFB], (float*)(ws + WS_C12), (float*)(ws + WS_C12) + DM, (bx - 49) * 8 + F.wave, 207 * 8);
            convert_range(F, args, I_A, I_B, (bx - 49) * 8 + F.wave, 207 * 8); }
        SEAM(1);
    }
    if (IN(2)) REP(2) {
        p2_ext(F);
        pg8::DenseSched<1> S{NPAN, NUP / 256, F.G, bx, 0, (const char*)(ws + WS_L_CQKV), (const char*)(ws + WS_W_UP), (size_t)256 * 1024 * 2, (size_t)256 * 512 * 2};
        pg8::EpiUp E{(const float*)(ws + WS_SSQ), (const float*)(ws + WS_CS), (bf16_t*)(ws + WS_L_QP), (bf16_t*)(ws + WS_L_KP), (bf16_t*)(ws + WS_L_VP)};
        pg8::gemm_phase(ring, 512, 1024, 512, S, E); SEAM(2);
    }
#if NAIVE_ATTN
    if (IN(3)) REP(3) { p3_attn_naive(F); SEAM(3); }
#else
    if (IN(3)) REP(3) { p3_attn(F, args); SEAM(3); }
#endif
    if (IN(4)) REP(4) {
        pg8::DenseSched<0> S{32, 8, F.G, bx, 1, (const char*)(ws + WS_L_O), (const char*)(ws + WS_W_OUT), (size_t)256 * DM * 2, (size_t)256 * DM * 2};
        pg8::EpiRes<0> E{(float*)(ws + WS_Y), nullptr, args.in[I_X], args.in[I_META], nullptr, nullptr};
        pg8::gemm_phase(ring, DM, DM, DM, S, E);
        skinny_meta<0>(F, (const bf16_t*)(ws + WS_L_O), DM, (const bf16_t*)(ws + WS_W_OUT), DM, (float*)(ws + WS_Y), args.in[I_META]); SEAM(4);
    }
    if (IN(5)) REP(5) { ln_phase(F, (const float*)(ws + WS_Y), args.in[I_LNMG], args.in[I_LNMB], (float*)(ws + WS_L_H1F), (bf16_t*)(ws + WS_L_H1B), true); SEAM(5); }
    if (IN(6)) REP(6) {
        pg8::DenseSched<0> S{NPAN, 2 * FFN / 256, F.G, bx, 0, (const char*)(ws + WS_L_H1B), (const char*)(ws + WS_W_GU), (size_t)256 * DM * 2, (size_t)256 * DM * 2};
        pg8::EpiGU E{(bf16_t*)(ws + WS_L_ACT), FFN};
        pg8::gemm_phase(ring, DM, DM, DM, S, E);
        if (F.G == 256 && bx >= 172) convert_range(F, args, I_B, I10, (bx - 172) * 8 + F.wave, 84 * 8);
        SEAM(6);
    }
    if (IN(7)) REP(7) {
        pg8::DenseSched<0> S{32, 8, F.G, bx, 1, (const char*)(ws + WS_L_ACT), (const char*)(ws + WS_W_DN), (size_t)256 * FFN * 2, (size_t)256 * FFN * 2};
        pg8::EpiResStat E{(float*)(ws + WS_Y), (const float*)(ws + WS_L_H1F), args.in[I_LNMG], args.in[I_LNMB], (bf16_t*)(ws + WS_L_H2B), (float*)(ws + WS_SLOT), F.lds};
        pg8::gemm_phase(ring, FFN, FFN, FFN, S, E);
        skinny_meta<1>(F, (const bf16_t*)(ws + WS_L_ACT), FFN, (const bf16_t*)(ws + WS_W_DN), FFN, (float*)(ws + WS_Y), (const float*)(ws + WS_L_H1F), args.in[I_LNMG], args.in[I_LNMB]); SEAM(7);
    }
    if (IN(9)) REP(9) {
        pg8::DenseSched<0> S{32, 8, F.G, bx, 1, (const char*)(ws + WS_L_H2B), (const char*)(ws + WS_W_PIN), (size_t)256 * DM * 2, (size_t)256 * DM * 2};
        pg8::EpiPoolIn E{(bf16_t*)(ws + WS_L_HP), (const float*)(ws + WS_SLOT), (const float*)(ws + WS_C12), (const float*)(ws + WS_C12) + DM, (float*)(ws + WS_L_H2F)};
        volatile LAS float* ms = (volatile LAS float*)(F.MISC + 208);
        meta_stats(F, (const float*)(ws + WS_Y), ms);
        pg8::gemm_phase(ring, DM, DM, DM, S, E);
        skinny_meta_ln(F, (const float*)(ws + WS_Y), ms, (const bf16_t*)(ws + WS_W_PIN), (const float*)(ws + WS_C12) + DM, (bf16_t*)(ws + WS_L_HP)); SEAM(9);
    }
    if (IN(10)) REP(10) { p10_pool(F); SEAM(10); }
    if (IN(11)) REP(11) {
        pg8::DenseSched<2> S{32, 8, F.G, bx, 1, (const char*)(ws + WS_L_PB), (const char*)(ws + WS_W_GRP), (size_t)256 * DM * 2, (size_t)256 * 512 * 2};
        pg8::EpiBf E{(bf16_t*)(ws + WS_L_YP)};
        pg8::gemm_phase(ring, 512, DM, 512, S, E); SEAM(11);
    }
    if (IN(12)) REP(12) {
        pg8::DenseSched<0> S{32, 8, F.G, bx, 1, (const char*)(ws + WS_L_YP), (const char*)(ws + WS_W_POUT), (size_t)256 * DM * 2, (size_t)256 * DM * 2};
        pg8::EpiRes<1> E{(float*)(ws + WS_Y), (const float*)(ws + WS_L_H2F), nullptr, nullptr, args.in[I_LNFG], args.in[I_LNFB]};
        pg8::gemm_phase(ring, DM, DM, DM, S, E); SEAM(12);
    }
    if (IN(13)) REP(13) { p13_ln_route(F, args); SEAM(13); }
    if (IN(14)) REP(14) {
        moe_tables(F, 2 * FE / 256);
        pg8::MoeSched<0> S{F.MISC, F.G, bx, 2 * FE / 256, (const char*)(ws + WS_M_XG), (const char*)(ws + WS_W_MGU), (size_t)DM, (size_t)2 * FE * DM, (size_t)256 * DM, 0};
        pg8::EpiGU8 E{ws + WS_M_ACT, F.MISC};
        pg8::gemm_phase<true>(ring, DM / 2, DM / 2, DM / 2, S, E); SEAM(14);
    }
    if (IN(15)) REP(15) {
        moe_tables_down(F);
        pg8::EpiMoeDown E{(bf16_t*)(ws + WS_M_XG), (bf16_t*)(ws + WS_M_XG + 64 * MiB), (const int*)(ws + WS_RINFO)};
        { pg8::MoeSched<1> S{F.MISC, F.G, bx, 8, (const char*)(ws + WS_M_ACT), (const char*)(ws + WS_W_MDN), (size_t)FE, (size_t)DM * FE, (size_t)256 * FE, 0};
          pg8::gemm_phase<true>(ring, FE / 2, FE / 2, FE / 2, S, E); }
        { pg8::MoeSched<1> S{F.MISC + 128, F.G, bx, 8 * KSB, (const char*)(ws + WS_M_ACT), (const char*)(ws + WS_W_MDN), (size_t)FE, (size_t)DM * FE, (size_t)256 * FE, (size_t)(FE / KSB)};
          pg8::gemm_phase<true>(ring, FE / KSB / 2, FE / 2, FE / 2, S, E); }
        SEAM(15);
    }
    if (IN(16)) REP(16) { p16_final(F, args); }
#undef IN
#undef SEAM
}

extern "C" void kernel_launch(void* const* d_in, const int* in_sizes, int n_in, void* d_out, int out_size, void* d_ws, size_t ws_size, hipStream_t stream) {
    static int grid = 0;
    if (grid == 0) {
        if (n_in != 25 || out_size != SEQ * DM || ws_size < WS_END) { fprintf(stderr, "kernel_launch: unexpected shapes (n_in %d, out %d, ws %zu < %zu)\n", n_in, out_size, ws_size, (size_t)WS_END); grid = -1; return; }
        int dev = 0, cus = 0, per_cu = 0;
        if (hipGetDevice(&dev) != hipSuccess || hipDeviceGetAttribute(&cus, hipDeviceAttributeMultiprocessorCount, dev) != hipSuccess) { grid = -1; return; }
        if (hipFuncSetAttribute((const void*)fwd, hipFuncAttributeMaxDynamicSharedMemorySize, LDS_BYTES) != hipSuccess) { fprintf(stderr, "kernel_launch: hipFuncSetAttribute failed\n"); grid = -1; return; }
        if (hipOccupancyMaxActiveBlocksPerMultiprocessor(&per_cu, (const void*)fwd, 512, LDS_BYTES) != hipSuccess || per_cu < 1) fprintf(stderr, "kernel_launch: occupancy query reports %d\n", per_cu);
        (void)hipGetLastError();
        grid = cus;
    }
    if (grid < 0) return;
    (void)hipMemsetAsync((char*)d_ws + WS_CTL, 0, CTL_ZERO_BYTES, stream);
    Args a{};
    for (int i = 0; i < 25; ++i) a.in[i] = (const float*)d_in[i];
    a.out = (float*)d_out; a.ws = (unsigned char*)d_ws;
#if MK_ONE_LAUNCH
    a.ph_lo = 0; a.ph_hi = NPHASE;
    hipLaunchKernelGGL(fwd, dim3(grid), dim3(512), LDS_BYTES, stream, a);
#else
    for (int p = 0; p < NPHASE; ++p) { a.ph_lo = p; a.ph_hi = p + 1; hipLaunchKernelGGL(fwd, dim3(grid), dim3(512), LDS_BYTES, stream, a); }
#endif
}
```

```cpp
#include <hip/hip_runtime.h>
#include <cstdio>
#include <cstdint>

#ifndef MK_ONE_LAUNCH
#define MK_ONE_LAUNCH 1
#endif
#ifndef DUP_MASK
#define DUP_MASK 0u
#endif
#ifndef NAIVE_ATTN
#define NAIVE_ATTN 0
#endif

#define GAS __attribute__((address_space(1)))
#define LAS __attribute__((address_space(3)))
typedef unsigned short bf16_t;
typedef short bf16x8 __attribute__((ext_vector_type(8)));
typedef float f32x4 __attribute__((ext_vector_type(4)));
typedef float f32x2 __attribute__((ext_vector_type(2)));
typedef unsigned u32x4 __attribute__((ext_vector_type(4)));
typedef unsigned u32x2 __attribute__((ext_vector_type(2)));

constexpr int DM = 2048, SEQ = 8192, NMETA = 16, LTOK = SEQ + NMETA;
constexpr int PADR = 240, ROW0 = 256, R = 8448, NPAN = 33;
constexpr int NH = 16, DKP = 192, DV = 128;
constexpr int NIN = 4352, NUP = 3584, FFN = 5632, NE = 8, FE = 7168, CAP = 8192, KS = 2;
constexpr float ALPHA = 1.41421356237309515f, LN_EPS = 1e-5f, RMS_EPS = 1e-6f;
constexpr float LOG2E = 1.4426950408889634f;
constexpr float QS_MLA = 0.07216878364870323f * LOG2E;
constexpr float SX8 = 16.f, SWGU8 = 512.f, SACT8 = 4.f, SWDN8 = 2048.f;
constexpr int FULL_TILES = 64, KSB = 7, OVF_ROWS = 2048;
constexpr float QS_FOX = 0.08838834764831845f * LOG2E;
__constant__ float INV_FREQ[32] = {1.000000000e+00f, 7.498942614e-01f, 5.623413324e-01f, 4.216965139e-01f, 3.162277639e-01f, 2.371373773e-01f, 1.778279394e-01f, 1.333521307e-01f,
    1.000000015e-01f, 7.498941571e-02f, 5.623413250e-02f, 4.216965288e-02f, 3.162277490e-02f, 2.371373773e-02f, 1.778279431e-02f, 1.333521493e-02f,
    9.999999776e-03f, 7.498941850e-03f, 5.623413250e-03f, 4.216964822e-03f, 3.162277630e-03f, 2.371373586e-03f, 1.778279431e-03f, 1.333521446e-03f,
    1.000000047e-03f, 7.498942432e-04f, 5.623413017e-04f, 4.216965172e-04f, 3.162277571e-04f, 2.371373703e-04f, 1.778279402e-04f, 1.333521504e-04f};

constexpr size_t MiB = 1u << 20;
constexpr size_t WS_CTL = 0, CTL_ZERO_BYTES = 65536;
constexpr size_t WS_CS = 1 * MiB;
constexpr size_t WS_SSQ = 3 * MiB + 256 * 1024;
constexpr size_t WS_SLOT = WS_SSQ;
constexpr size_t WS_C12 = 3 * MiB + 128 * 1024;
constexpr size_t WS_W_IN = 4 * MiB;
constexpr size_t WS_W_UP = 21 * MiB;
constexpr size_t WS_W_OUT = 25 * MiB;
constexpr size_t WS_W_GU = 33 * MiB;
constexpr size_t WS_W_DN = 77 * MiB;
constexpr size_t WS_W_PIN = 99 * MiB;
constexpr size_t WS_W_GRP = 107 * MiB;
constexpr size_t WS_W_POUT = 109 * MiB;
constexpr size_t WS_W_MGU = 117 * MiB;
constexpr size_t WS_W_MDN = 565 * MiB;
constexpr size_t WS_Y = 789 * MiB;
constexpr size_t WS_H3F = 855 * MiB;
constexpr size_t WS_RINFO = 921 * MiB;
constexpr size_t WS_TOKG = 921 * MiB + 512 * 1024;
constexpr size_t WS_OV = 922 * MiB;
constexpr size_t WS_L_CQKV = 922 * MiB;
constexpr size_t WS_L_KR = 939 * MiB;
constexpr size_t WS_L_LF = 941 * MiB + 512 * 1024;
constexpr size_t WS_L_QP = 942 * MiB;
constexpr size_t WS_L_KP = 992 * MiB;
constexpr size_t WS_L_VP = 1042 * MiB;
constexpr size_t WS_L_O = 1075 * MiB;
constexpr size_t WS_L_H1F = 1108 * MiB;
constexpr size_t WS_L_H1B = 1174 * MiB;
constexpr size_t WS_L_ACT = 1207 * MiB;
constexpr size_t WS_L_H2F = 1298 * MiB;
constexpr size_t WS_L_H2B = 1364 * MiB;
constexpr size_t WS_L_HP = 1397 * MiB;
constexpr size_t WS_L_PB = 1463 * MiB;
constexpr size_t WS_L_YP = 1496 * MiB;
constexpr size_t WS_L_H0B = 1529 * MiB;
constexpr size_t WS_END = 1562 * MiB;
constexpr size_t WS_M_XG = 922 * MiB;
constexpr size_t WS_M_ACT = 1178 * MiB;
constexpr int CW_TMO = 0, CW_CODE = 1, CW_BAR = 4096, CW_CNT = 8192;

constexpr int RING_BYTES = 151552;
constexpr int LDS_PSTAT = 131072;
constexpr int MISC_OFF = RING_BYTES;
constexpr int LDS_BYTES = 155648;

__device__ __forceinline__ unsigned cvt_pk_bf16(float lo, float hi) { unsigned r; asm volatile("v_cvt_pk_bf16_f32 %0, %1, %2" : "=v"(r) : "v"(lo), "v"(hi)); return r; }
__device__ __forceinline__ u32x4 pack8(f32x4 a, f32x4 b) { u32x4 w; w.x = cvt_pk_bf16(a[0], a[1]); w.y = cvt_pk_bf16(a[2], a[3]); w.z = cvt_pk_bf16(b[0], b[1]); w.w = cvt_pk_bf16(b[2], b[3]); return w; }
__device__ __forceinline__ u32x2 pack4(f32x4 a) { u32x2 w; w.x = cvt_pk_bf16(a[0], a[1]); w.y = cvt_pk_bf16(a[2], a[3]); return w; }
__device__ __forceinline__ float bf_lo(unsigned w) { return __uint_as_float(w << 16); }
__device__ __forceinline__ float bf_hi(unsigned w) { return __uint_as_float(w & 0xffff0000u); }
__device__ __forceinline__ float bf2f(bf16_t b) { return __uint_as_float(((unsigned)b) << 16); }
__device__ __forceinline__ bf16_t f2bf(float f) { return (bf16_t)(cvt_pk_bf16(f, 0.f) & 0xffffu); }
__device__ __forceinline__ float wave_sum(float v) {
#pragma unroll
    for (int o = 1; o < 64; o <<= 1) v += __shfl_xor(v, o);
    return v;
}
__device__ __forceinline__ float wave_max(float v) {
#pragma unroll
    for (int o = 1; o < 64; o <<= 1) v = fmaxf(v, __shfl_xor(v, o));
    return v;
}
__device__ __forceinline__ double wave_sum_d(double v) {
#pragma unroll
    for (int o = 1; o < 64; o <<= 1) v += __shfl_xor(v, o);
    return v;
}

#ifndef BG_IN_ATTN
#define BG_IN_ATTN 1
#endif
#ifndef BG_IN_PROLOGUE
#define BG_IN_PROLOGUE 0
#endif
#ifndef GEMM_SP2
#define GEMM_SP2 true
#endif
#ifndef EPI_TWICE
#define EPI_TWICE 0
#endif
#ifndef MOE_WGM
#define MOE_WGM 8
#endif
#ifndef FP8_EMU
#define FP8_EMU 0
#endif
__device__ __forceinline__ void q8pair(float& a, float& b, float sc) {
    float x = fminf(fmaxf(a * sc, -448.f), 448.f), y = fminf(fmaxf(b * sc, -448.f), 448.f);
    const int p = __builtin_amdgcn_cvt_pk_fp8_f32(x, y, 0, false); const float is = 1.0f / sc;
    a = __builtin_amdgcn_cvt_f32_fp8(p, 0) * is; b = __builtin_amdgcn_cvt_f32_fp8(p, 1) * is;
}
__device__ __forceinline__ f32x4 q8v(f32x4 v, float sc) { float a = v[0], b = v[1], c = v[2], d = v[3]; q8pair(a, b, sc); q8pair(c, d, sc); return (f32x4){a, b, c, d}; }
__device__ __forceinline__ unsigned pack4_fp8(float a, float b, float c, float d) {
    a = fminf(fmaxf(a, -448.f), 448.f); b = fminf(fmaxf(b, -448.f), 448.f); c = fminf(fmaxf(c, -448.f), 448.f); d = fminf(fmaxf(d, -448.f), 448.f);
    int p = __builtin_amdgcn_cvt_pk_fp8_f32(a, b, 0, false); p = __builtin_amdgcn_cvt_pk_fp8_f32(c, d, p, true); return (unsigned)p; }
typedef short s16x2_t __attribute__((ext_vector_type(2)));
__device__ __forceinline__ unsigned pack4_fp8_sc(float a, float b, float c, float d, float inv) {
    const s16x2_t lo = __builtin_amdgcn_cvt_scalef32_pk_fp8_f32((s16x2_t){0, 0}, a, b, inv, false);
    return __builtin_bit_cast(unsigned, __builtin_amdgcn_cvt_scalef32_pk_fp8_f32(lo, c, d, inv, true)); }
#define LDS_WAIT() asm volatile("s_waitcnt lgkmcnt(0)" ::: "memory")
#define VM_WAIT() asm volatile("s_waitcnt vmcnt(0)" ::: "memory")

namespace pg8 {
constexpr int BM = 256, BK = 64, HALF = 128, HTB = HALF * BK * 2, STAGE_BYTES = 8 * HTB, NXCD = 8, WGM = 8;
__host__ __device__ __forceinline__ int lds_byte(int r, int c) { const int st = (r >> 4) * 2 + (c >> 5), rr = r & 15, cc = c & 31, ob = rr * 64 + cc * 2; return st * 1024 + (ob ^ (((ob >> 9) & 1) << 5)); }
__host__ __device__ __forceinline__ void stage_rc(int b, int& Rr, int& C) { const int st = b / 1024, sb = b % 1024, swz = sb ^ (((sb >> 9) & 1) << 5); Rr = (st >> 1) * 16 + swz / 64; C = (st & 1) * 32 + (swz % 64) / 2; }
__host__ __device__ __forceinline__ int perm32(int rho) { const int n = rho >> 4, i = rho & 15; return 8 * (i >> 2) + 4 * n + (i & 3); }

struct Unit { int pm, pn, e, ks, nvalid, aux; const char* A; const char* B; };

__device__ __forceinline__ bool tile_order(int i, int G, int c, int nM, int nN, int& pm, int& pn) {
    const int nwg = nM * nN; const long L = (long)i * G + c; if (L >= nwg) return false;
    int wgid = (int)L; { const int q = nwg / NXCD, r = nwg % NXCD, xcd = wgid % NXCD, off = wgid / NXCD; wgid = (xcd < r ? xcd * (q + 1) : r * (q + 1) + (xcd - r) * q) + off; }
    const int nig = WGM * nN, gid = wgid / nig, fm = gid * WGM, gsz = (nM - fm) < WGM ? (nM - fm) : WGM;
    pm = fm + ((wgid % nig) % gsz); pn = (wgid % nig) / gsz; return true;
}
template <int KIND> struct DenseSched {
    int nM, nN, G, c, pm0; const char* A; const char* B; size_t a_tile, b_tile;
    __device__ __forceinline__ bool next(int i, Unit& u) const {
        int pm, pn; if (!tile_order(i, G, c, nM, nN, pm, pn)) return false;
        u.pm = pm + pm0; u.pn = pn; u.e = 0; u.ks = 0; u.nvalid = 256; u.aux = 0;
        size_t aoff = 0; if (KIND == 1) aoff = pn >= 6 ? 1024 : 0; if (KIND == 2) aoff = (size_t)(pn >> 1) * 1024;
        u.A = A + (size_t)(pm + pm0) * a_tile + aoff; u.B = B + (size_t)pn * b_tile; return true;
    }
};
template <int DOWN> struct MoeSched {
    const volatile LAS int* mt; int G, c, nNx; const char* A; const char* B; size_t a_row, b_exp, b_tile, ks_bytes;
    __device__ __forceinline__ int rd(int i) const { return __builtin_amdgcn_readfirstlane(mt[i]); }
    __device__ __forceinline__ bool next(int i, Unit& u) const {
        const int U = rd(24); const long L = (long)i * G + c; if (L >= U) return false;
        int idx = (int)L; { const int q = U / NXCD, r = U % NXCD, xcd = idx % NXCD, off = idx / NXCD; idx = (xcd < r ? xcd * (q + 1) : r * (q + 1) + (xcd - r) * q) + off; }
        int e = 0;
#pragma unroll
        for (int j = 1; j < 8; ++j) if (idx >= rd(16 + j)) e = j;
        constexpr int GM = MOE_WGM; const int l = idx - rd(16 + e), nM = rd(8 + e), nig = GM * nNx, gid = l / nig, fm = gid * GM, gsz = (nM - fm) < GM ? (nM - fm) : GM;
        const int pml = fm + ((l % nig) % gsz), jn = (l % nig) / gsz, pm = DOWN ? pml + rd(40 + e) : pml;
        u.pm = pm; u.e = e; u.nvalid = rd(e) - pm * 256; u.aux = DOWN ? rd(48 + e) + pml : 0;
        if (DOWN) { u.pn = jn & 7; u.ks = jn >> 3; u.A = A + (size_t)(rd(32 + e) + pm * 256) * a_row + (size_t)u.ks * ks_bytes; u.B = B + (size_t)e * b_exp + (size_t)u.pn * b_tile + (size_t)u.ks * ks_bytes; }
        else { u.pn = jn; u.ks = 0; u.A = A + (size_t)(e * CAP + pm * 256) * a_row; u.B = B + (size_t)e * b_exp + (size_t)jn * b_tile; }
        return true;
    }
};

typedef f32x4 Acc[2][2][4][2];
typedef int i32x8 __attribute__((ext_vector_type(8)));
typedef int i32x4 __attribute__((ext_vector_type(4)));
__device__ __forceinline__ i32x8 cat8(bf16x8 lo, bf16x8 hi) { const i32x4 a = __builtin_bit_cast(i32x4, lo), b = __builtin_bit_cast(i32x4, hi); return __builtin_shufflevector(a, b, 0, 1, 2, 3, 4, 5, 6, 7); }

typedef double f64x2 __attribute__((ext_vector_type(2)));
__device__ __forceinline__ f32x4 zero4() { f64x2 z; asm volatile("v_mov_b64 %0, 0" : "=v"(z.x)); asm volatile("v_mov_b64 %0, 0" : "=v"(z.y)); return __builtin_bit_cast(f32x4, z); }
template <bool FP8 = false, bool SP2 = GEMM_SP2, class Epi, class Sched>
__device__ __forceinline__ void gemm_phase(LAS unsigned char* lds, const int K, const int lda, const int ldb, const Sched& S, const Epi& E) {
    const int tid = threadIdx.x, wid = __builtin_amdgcn_readfirstlane(tid >> 6), lane = tid & 63, wr = wid >> 2, wc = wid & 3, fr = lane & 15, fq = lane >> 4;
    const int nt = K / BK;
    unsigned voffA[2], voffB[2];
#pragma unroll
    for (int i = 0; i < 2; ++i) { int Rr, C; stage_rc(tid * 16 + i * 8192, Rr, C); const int Rb = (Rr & ~31) + perm32(Rr & 31);
        voffA[i] = (unsigned)(Rr * lda + C) * 2u; voffB[i] = (unsigned)(Rb * ldb + C) * 2u; }
    const size_t kstep = (size_t)(BK * 2);
    const size_t hstepA = (size_t)HALF * lda * 2, hstepB = (size_t)HALF * ldb * 2;
    const unsigned ldsw = (unsigned)wid * 1024u;
    const int aoff = lds_byte(wr * 64 + fr, fq * 8), boff = lds_byte(wc * 32 + fr, fq * 8);
#define PG8_SA(b, h) (((b) * 2 + (h)) * HTB)
#define PG8_SB(b, h) ((4 + (b) * 2 + (h)) * HTB)
#define PG8_STAGE(bufoff, gbase, voff) do { _Pragma("unroll") for (int _i = 0; _i < 2; ++_i) \
        __builtin_amdgcn_global_load_lds((const unsigned*)((const char*)(gbase) + (voff)[_i]), (LAS unsigned*)(lds + (bufoff) + ldsw + _i * 8192), 16, 0, 0); } while (0)
#define PG8_LD8(p) __builtin_shufflevector(*(const LAS i32x4*)(p), *(const LAS i32x4*)((p) + 1024), 0, 1, 2, 3, 4, 5, 6, 7)
#define PG8_LDA(dst, b, h) do { if constexpr (FP8) { _Pragma("unroll") for (int m = 0; m < 4; ++m) dst##8[m] = PG8_LD8(lds + PG8_SA(b, h) + aoff + m * 2048); } \
        else { _Pragma("unroll") for (int m = 0; m < 4; ++m) _Pragma("unroll") for (int k = 0; k < 2; ++k) dst[m][k] = *(const LAS bf16x8*)(lds + PG8_SA(b, h) + aoff + m * 2048 + k * 1024); } } while (0)
#define PG8_LDB(dst, b, h) do { if constexpr (FP8) { _Pragma("unroll") for (int n = 0; n < 2; ++n) dst##8[n] = PG8_LD8(lds + PG8_SB(b, h) + boff + n * 2048); } \
        else { _Pragma("unroll") for (int n = 0; n < 2; ++n) _Pragma("unroll") for (int k = 0; k < 2; ++k) dst[n][k] = *(const LAS bf16x8*)(lds + PG8_SB(b, h) + boff + n * 2048 + k * 1024); } } while (0)
#define PG8_MMA(ai, bj, At, Bt) do { __builtin_amdgcn_s_setprio(1); _Pragma("unroll") for (int m = 0; m < 4; ++m) _Pragma("unroll") for (int n = 0; n < 2; ++n) { \
        if constexpr (FP8) asm volatile("v_mfma_scale_f32_16x16x128_f8f6f4 %0, %1, %2, %0, %3, %3 op_sel_hi:[0,0,0]" : "+v"(acc[ai][bj][m][n]) : "v"(Bt##8[n]), "v"(At##8[m]), "v"(one8)); \
        else { _Pragma("unroll") for (int k = 0; k < 2; ++k) acc[ai][bj][m][n] = __builtin_amdgcn_mfma_f32_16x16x32_bf16(Bt[n][k], At[m][k], acc[ai][bj][m][n], 0, 0, 0); } } __builtin_amdgcn_s_setprio(0); } while (0)
#define PG8_WAIT_V(n) asm volatile("s_waitcnt vmcnt(" #n ")" ::: "memory")
#define PG8_WAIT_L(n) asm volatile("s_waitcnt lgkmcnt(" #n ")" ::: "memory")
#define PG8_BAR __builtin_amdgcn_s_barrier()
#define PG8_SCHED __builtin_amdgcn_sched_barrier(0)
    Unit cur, nxt; int ui = 0;
    if (!S.next(0, cur)) return;
    Acc acc;
#pragma unroll
    for (int a = 0; a < 2; ++a)
#pragma unroll
        for (int b = 0; b < 2; ++b)
#pragma unroll
            for (int m = 0; m < 4; ++m)
#pragma unroll
                for (int n = 0; n < 2; ++n) acc[a][b][m][n] = (f32x4){0.f, 0.f, 0.f, 0.f};
    bf16x8 At[4][2], B0[2][2], B1[2][2];
    const int one8 = 0x7f7f7f7f;
    i32x8 At8[4], B08[2], B18[2];
    const char* cA = cur.A; const char* cB = cur.B;
    if constexpr (SP2) {
    PG8_STAGE(PG8_SB(0, 0), cB, voffB); PG8_STAGE(PG8_SB(0, 1), cB + hstepB, voffB); PG8_STAGE(PG8_SA(0, 0), cA, voffA); PG8_STAGE(PG8_SA(0, 1), cA + hstepA, voffA);
    if (wr == 1) PG8_BAR;
    PG8_WAIT_V(2); PG8_BAR;
    PG8_STAGE(PG8_SB(1, 0), cB + kstep, voffB); PG8_STAGE(PG8_SA(1, 0), cA + kstep, voffA); PG8_STAGE(PG8_SB(1, 1), cB + hstepB + kstep, voffB);
    PG8_WAIT_V(6); PG8_BAR;
    } else {
    PG8_STAGE(PG8_SB(0, 0), cB, voffB); PG8_STAGE(PG8_SA(0, 0), cA, voffA); PG8_STAGE(PG8_SB(0, 1), cB + hstepB, voffB); PG8_STAGE(PG8_SA(0, 1), cA + hstepA, voffA);
    if (wr == 1) PG8_BAR;
    PG8_WAIT_V(4); PG8_BAR;
    PG8_STAGE(PG8_SB(1, 0), cB + kstep, voffB); PG8_STAGE(PG8_SA(1, 0), cA + kstep, voffA); PG8_STAGE(PG8_SB(1, 1), cB + hstepB + kstep, voffB);
    PG8_WAIT_V(6); PG8_BAR;
    }
    for (;;) {
        const bool has_next = S.next(ui + 1, nxt);
        const char* nA = has_next ? nxt.A : cA; const char* nB = has_next ? nxt.B : cB;
        for (int t = 0; t < nt; t += 2) {
            const bool last = (t == nt - 2);
            const char* a1 = cA + (size_t)(t + 1) * kstep;
            const char* a2 = last ? nA : cA + (size_t)(t + 2) * kstep; const char* b2 = last ? nB : cB + (size_t)(t + 2) * kstep;
            const char* a3 = a2 + kstep; const char* b3 = b2 + kstep;
            if constexpr (SP2) {
            PG8_LDB(B0, 0, 0); PG8_LDB(B1, 0, 1); PG8_SCHED; PG8_LDA(At, 0, 0); PG8_STAGE(PG8_SA(1, 1), a1 + hstepA, voffA);
            PG8_WAIT_V(8); PG8_WAIT_L(0); PG8_BAR; PG8_MMA(0, 0, At, B0); PG8_MMA(0, 1, At, B1); PG8_BAR; PG8_SCHED;
            PG8_LDA(At, 0, 1); PG8_STAGE(PG8_SB(0, 0), b2, voffB); PG8_STAGE(PG8_SB(0, 1), b2 + hstepB, voffB); PG8_STAGE(PG8_SA(0, 0), a2, voffA);
            PG8_WAIT_V(8); PG8_WAIT_L(0); PG8_BAR; PG8_MMA(1, 0, At, B0); PG8_MMA(1, 1, At, B1); PG8_BAR; PG8_SCHED;
            PG8_LDB(B0, 1, 0); PG8_LDB(B1, 1, 1); PG8_SCHED; PG8_LDA(At, 1, 0); PG8_STAGE(PG8_SA(0, 1), a2 + hstepA, voffA);
            PG8_WAIT_V(8); PG8_WAIT_L(0); PG8_BAR; PG8_MMA(0, 0, At, B0); PG8_MMA(0, 1, At, B1); PG8_BAR; PG8_SCHED;
            PG8_LDA(At, 1, 1); PG8_STAGE(PG8_SB(1, 0), b3, voffB); PG8_STAGE(PG8_SB(1, 1), b3 + hstepB, voffB); PG8_STAGE(PG8_SA(1, 0), a3, voffA);
            PG8_WAIT_V(8); PG8_WAIT_L(0); PG8_BAR; PG8_MMA(1, 0, At, B0); PG8_MMA(1, 1, At, B1); PG8_BAR; PG8_SCHED;
            } else {
            PG8_LDB(B0, 0, 0); PG8_SCHED; PG8_LDA(At, 0, 0); PG8_STAGE(PG8_SA(1, 1), a1 + hstepA, voffA);
            PG8_WAIT_L(8); PG8_BAR; PG8_WAIT_L(0); PG8_MMA(0, 0, At, B0); PG8_BAR; PG8_SCHED;
            PG8_LDB(B1, 0, 1); PG8_STAGE(PG8_SB(0, 0), b2, voffB);
            PG8_BAR; PG8_WAIT_L(0); PG8_MMA(0, 1, At, B1); PG8_BAR;
            PG8_LDA(At, 0, 1); PG8_STAGE(PG8_SA(0, 0), a2, voffA);
            PG8_BAR; PG8_WAIT_L(0); PG8_MMA(1, 0, At, B0); PG8_BAR; PG8_SCHED;
            PG8_STAGE(PG8_SB(0, 1), b2 + hstepB, voffB);
            PG8_WAIT_V(6); PG8_BAR; PG8_MMA(1, 1, At, B1); PG8_BAR;
            PG8_LDB(B0, 1, 0); PG8_SCHED; PG8_LDA(At, 1, 0); PG8_STAGE(PG8_SA(0, 1), a2 + hstepA, voffA);
            PG8_WAIT_L(8); PG8_BAR; PG8_WAIT_L(0); PG8_MMA(0, 0, At, B0); PG8_BAR; PG8_SCHED;
            PG8_LDB(B1, 1, 1); PG8_STAGE(PG8_SB(1, 0), b3, voffB);
            PG8_BAR; PG8_WAIT_L(0); PG8_MMA(0, 1, At, B1); PG8_BAR;
            PG8_LDA(At, 1, 1); PG8_STAGE(PG8_SA(1, 0), a3, voffA);
            PG8_BAR; PG8_WAIT_L(0); PG8_MMA(1, 0, At, B0); PG8_BAR; PG8_SCHED;
            PG8_STAGE(PG8_SB(1, 1), b3 + hstepB, voffB);
            PG8_WAIT_V(6); PG8_BAR; PG8_MMA(1, 1, At, B1); PG8_BAR;
            }
        }
        if constexpr (FP8) asm volatile("s_nop 15\n\ts_nop 15" ::: "memory");
        if (wr == 0) PG8_BAR;
        { int fr2 = fr, fq2 = fq; asm volatile("" : "+v"(fr2), "+v"(fq2)); E(acc, cur, wr, wc, fr2, fq2); if constexpr (FP8 && EPI_TWICE) { asm volatile("" : "+v"(fr2), "+v"(fq2)); E(acc, cur, wr, wc, fr2, fq2); } }
        if (!has_next) break;
#pragma unroll
        for (int a = 0; a < 2; ++a)
#pragma unroll
            for (int b = 0; b < 2; ++b)
#pragma unroll
                for (int m = 0; m < 4; ++m)
#pragma unroll
                    for (int n = 0; n < 2; ++n) acc[a][b][m][n] = zero4();
        cur = nxt; cA = nA; cB = nB; ++ui;
        if (wr == 1) PG8_BAR;
    }
    PG8_WAIT_V(0);
    PG8_BAR;
#undef PG8_SA
#undef PG8_SB
#undef PG8_STAGE
#undef PG8_LDA
#undef PG8_LD8
#undef PG8_LDB
#undef PG8_MMA
#undef PG8_WAIT_V
#undef PG8_WAIT_L
#undef PG8_BAR
#undef PG8_SCHED
}

#define EPI_ROWS _Pragma("unroll") for (int ai = 0; ai < 2; ++ai) _Pragma("unroll") for (int m = 0; m < 4; ++m)
#define EPI_RL (ai * 128 + wr * 64 + m * 16 + fr)

struct EpiIn {
    unsigned char* ws; const float* fbias;
    __device__ __forceinline__ void operator()(const Acc& acc, const Unit& u, int wr, int wc, int fr, int fq) const {
        const int pn = u.pn, c8 = wc * 32 + fq * 8;
        bf16_t* cqkv = (bf16_t*)(ws + WS_L_CQKV); float* ssq = (float*)(ws + WS_SSQ); float* kr = (float*)(ws + WS_L_KR); float* lf = (float*)(ws + WS_L_LF);
        if (pn < 4) {
            EPI_ROWS { const int row = u.pm * 256 + EPI_RL; float s = 0.f;
#pragma unroll
                for (int bj = 0; bj < 2; ++bj) { const f32x4 v0 = acc[ai][bj][m][0], v1 = acc[ai][bj][m][1];
                    *(u32x4*)(cqkv + (size_t)row * 1024 + pn * 256 + bj * 128 + c8) = pack8(v0, v1);
                    float t = v0[0] * v0[0] + v0[1] * v0[1] + v0[2] * v0[2] + v0[3] * v0[3] + v1[0] * v1[0] + v1[1] * v1[1] + v1[2] * v1[2] + v1[3] * v1[3];
                    t += __shfl_xor(t, 16); t += __shfl_xor(t, 32); s += t; }
                if (fq == 0) ssq[((size_t)(pn >> 1) * R + row) * 8 + (pn & 1) * 4 + wc] = s; }
        } else if (pn < 16) {
            const size_t toff = pn < 8 ? WS_L_QP : (pn < 12 ? WS_L_KP : WS_L_VP); bf16_t* T = (bf16_t*)(ws + toff); const int t = (pn - 4) & 3, width = pn < 12 ? DKP : DV; const float sc = pn < 8 ? QS_FOX : 1.f;
            EPI_ROWS { const int row = u.pm * 256 + EPI_RL;
#pragma unroll
                for (int bj = 0; bj < 2; ++bj) { const int head = 8 + 2 * t + bj;
                    *(u32x4*)(T + ((size_t)head * R + row) * width + c8) = pack8(acc[ai][bj][m][0] * sc, acc[ai][bj][m][1] * sc); } }
        } else {
            EPI_ROWS { const int row = u.pm * 256 + EPI_RL; const f32x4 v0 = acc[ai][0][m][0], v1 = acc[ai][0][m][1];
                if (wc < 2) { *(f32x4*)(kr + (size_t)row * 64 + c8) = v0; *(f32x4*)(kr + (size_t)row * 64 + c8 + 4) = v1; }
                else if (wc == 2 && fq == 0) { f32x4 o0, o1;
#pragma unroll
                    for (int j = 0; j < 4; ++j) { const float x0 = v0[j] + fbias[j], x1 = v1[j] + fbias[4 + j];
                        o0[j] = fminf(x0, 0.f) - log1pf(expf(-fabsf(x0))); o1[j] = fminf(x1, 0.f) - log1pf(expf(-fabsf(x1))); }
                    *(f32x4*)(lf + (size_t)row * 8) = o0; *(f32x4*)(lf + (size_t)row * 8 + 4) = o1; } }
        }
    }
};
struct EpiUp {
    const float* ssq; const float* cs; bf16_t *qp, *kp, *vp;
    __device__ __forceinline__ void operator()(const Acc& acc, const Unit& u, int wr, int wc, int fr, int fq) const {
        const int pn = u.pn, c8 = wc * 32 + fq * 8, which = pn < 6 ? 0 : 1;
        EPI_ROWS { const int row = u.pm * 256 + EPI_RL;
            const f32x4 s0 = *(const f32x4*)(ssq + ((size_t)which * R + row) * 8), s1 = *(const f32x4*)(ssq + ((size_t)which * R + row) * 8 + 4);
            const float ss = ((s0[0] + s0[1]) + (s0[2] + s0[3])) + ((s1[0] + s1[1]) + (s1[2] + s1[3]));
            const float rr = 1.0f / sqrtf(ss * (1.0f / 512.0f) + RMS_EPS);
            if (pn < 4) { const float sc = rr * QS_MLA;
#pragma unroll
                for (int bj = 0; bj < 2; ++bj) *(u32x4*)(qp + ((size_t)(2 * pn + bj) * R + row) * DKP + c8) = pack8(acc[ai][bj][m][0] * sc, acc[ai][bj][m][1] * sc);
            } else if (pn < 6) { const float sc = rr * QS_MLA; const int q8 = 4 * (wc & 1) + fq;
                const f32x4 C = *(const f32x4*)(cs + (size_t)row * 64 + 4 * q8), Sn = *(const f32x4*)(cs + (size_t)row * 64 + 32 + 4 * q8);
#pragma unroll
                for (int bj = 0; bj < 2; ++bj) { const int head = 4 * (pn - 4) + 2 * bj + (wc >> 1); const f32x4 x1 = acc[ai][bj][m][0] * sc, x2 = acc[ai][bj][m][1] * sc;
                    bf16_t* q = qp + ((size_t)head * R + row) * DKP + 128 + 4 * q8;
                    *(u32x2*)q = pack4(x1 * C - x2 * Sn); *(u32x2*)(q + 32) = pack4(x2 * C + x1 * Sn); }
            } else if (pn < 10) {
#pragma unroll
                for (int bj = 0; bj < 2; ++bj) *(u32x4*)(kp + ((size_t)(2 * (pn - 6) + bj) * R + row) * DKP + c8) = pack8(acc[ai][bj][m][0] * rr, acc[ai][bj][m][1] * rr);
            } else {
#pragma unroll
                for (int bj = 0; bj < 2; ++bj) *(u32x4*)(vp + ((size_t)(2 * (pn - 10) + bj) * R + row) * DV + c8) = pack8(acc[ai][bj][m][0] * rr, acc[ai][bj][m][1] * rr);
            }
        }
    }
};
template <int MODE> struct EpiRes {
    float* Y; const float* stats; const float* x; const float* meta; const float* g; const float* b;
    __device__ __forceinline__ void operator()(const Acc& acc, const Unit& u, int wr, int wc, int fr, int fq) const {
        const int c8 = wc * 32 + fq * 8;
        EPI_ROWS { const int row = u.pm * 256 + EPI_RL;
            const float* rp; float mean = 0.f, rstd = 0.f;
            if (MODE == 1) { rp = Y + (size_t)row * DM; const f32x2 st = *(const f32x2*)(stats + (size_t)row * 2); mean = st.x; rstd = st.y; }
            else rp = row >= ROW0 ? x + (size_t)(row - ROW0) * DM : (row >= PADR ? meta + (size_t)(row - PADR) * DM : nullptr);
#pragma unroll
            for (int bj = 0; bj < 2; ++bj) { const int col = u.pn * 256 + bj * 128 + c8;
                f32x4 r0 = (f32x4){0.f, 0.f, 0.f, 0.f}, r1 = r0; if (MODE == 1 || rp) { r0 = *(const f32x4*)(rp + col); r1 = *(const f32x4*)(rp + col + 4); }
                if (MODE == 1) {
                    r0 = (r0 - mean) * rstd * *(const f32x4*)(g + col) + *(const f32x4*)(b + col); r1 = (r1 - mean) * rstd * *(const f32x4*)(g + col + 4) + *(const f32x4*)(b + col + 4); }
                *(f32x4*)(Y + (size_t)row * DM + col) = r0 * ALPHA + acc[ai][bj][m][0]; *(f32x4*)(Y + (size_t)row * DM + col + 4) = r1 * ALPHA + acc[ai][bj][m][1]; }
        }
    }
};
struct EpiResStat {
    float* Y; const float* stats; const float* g; const float* b; bf16_t* Y16; float* slots; LAS unsigned char* lds;
    __device__ __forceinline__ void operator()(const Acc& acc, const Unit& u, int wr, int wc, int fr, int fq) const {
        const int c8 = wc * 32 + fq * 8; LAS f32x2* P = (LAS f32x2*)(lds + LDS_PSTAT);
        EPI_ROWS { const int rl = EPI_RL, row = u.pm * 256 + rl; float* rp = Y + (size_t)row * DM; const f32x2 st = *(const f32x2*)(stats + (size_t)row * 2); float sm = 0.f, sq = 0.f;
#pragma unroll
            for (int bj = 0; bj < 2; ++bj) { const int col = u.pn * 256 + bj * 128 + c8;
                f32x4 r0 = *(const f32x4*)(rp + col), r1 = *(const f32x4*)(rp + col + 4);
                r0 = (r0 - st.x) * st.y * *(const f32x4*)(g + col) + *(const f32x4*)(b + col); r1 = (r1 - st.x) * st.y * *(const f32x4*)(g + col + 4) + *(const f32x4*)(b + col + 4);
                const f32x4 y0 = r0 * ALPHA + acc[ai][bj][m][0], y1 = r1 * ALPHA + acc[ai][bj][m][1];
                *(f32x4*)(rp + col) = y0; *(f32x4*)(rp + col + 4) = y1; *(u32x4*)(Y16 + (size_t)row * DM + col) = pack8(y0, y1);
                sm += ((y0[0] + y0[1]) + (y0[2] + y0[3])) + ((y1[0] + y1[1]) + (y1[2] + y1[3]));
                sq += ((y0[0] * y0[0] + y0[1] * y0[1]) + (y0[2] * y0[2] + y0[3] * y0[3])) + ((y1[0] * y1[0] + y1[1] * y1[1]) + (y1[2] * y1[2] + y1[3] * y1[3])); }
            sm += __shfl_xor(sm, 16); sm += __shfl_xor(sm, 32); sq += __shfl_xor(sq, 16); sq += __shfl_xor(sq, 32);
            if (fq == 0) P[rl * 4 + wc] = (f32x2){sm, sq}; }
        asm volatile("s_waitcnt lgkmcnt(0)" ::: "memory"); __builtin_amdgcn_s_barrier(); asm volatile("" ::: "memory");
        const int t = threadIdx.x;
        if (t < 256) { const f32x2 a = P[t * 4 + 0], bb = P[t * 4 + 1], c = P[t * 4 + 2], d = P[t * 4 + 3];
            *(f32x2*)(slots + ((size_t)(u.pm * 256 + t) * 8 + u.pn) * 2) = (f32x2){(a.x + bb.x) + (c.x + d.x), (a.y + bb.y) + (c.y + d.y)}; }
    }
};
struct EpiPoolIn {
    bf16_t* HP; const float* slots; const float* c1; const float* c2; float* stats;
    __device__ __forceinline__ void operator()(const Acc& acc, const Unit& u, int wr, int wc, int fr, int fq) const {
        const int c8 = wc * 32 + fq * 8;
        EPI_ROWS { const int row = u.pm * 256 + EPI_RL; const f32x4* sp = (const f32x4*)(slots + (size_t)row * 16); const f32x4 a = sp[0], bb = sp[1], c = sp[2], d = sp[3];
            const float S = ((a[0] + a[2]) + (bb[0] + bb[2])) + ((c[0] + c[2]) + (d[0] + d[2])), Q = ((a[1] + a[3]) + (bb[1] + bb[3])) + ((c[1] + c[3]) + (d[1] + d[3]));
            const float mean = S * (1.0f / DM), var = Q * (1.0f / DM) - mean * mean, rstd = 1.0f / sqrtf(var + LN_EPS);
            if (u.pn == 0 && wc == 0 && fq == 0) *(f32x2*)(stats + (size_t)row * 2) = (f32x2){mean, rstd};
#pragma unroll
            for (int bj = 0; bj < 2; ++bj) { const int col = u.pn * 256 + bj * 128 + c8;
                const f32x4 v0 = (acc[ai][bj][m][0] - *(const f32x4*)(c1 + col) * mean) * rstd + *(const f32x4*)(c2 + col);
                const f32x4 v1 = (acc[ai][bj][m][1] - *(const f32x4*)(c1 + col + 4) * mean) * rstd + *(const f32x4*)(c2 + col + 4);
                *(u32x4*)(HP + (size_t)row * DM + col) = pack8(v0, v1); } }
    }
};
__device__ __forceinline__ float silu_mul(float g, float uu) { return g * __builtin_amdgcn_rcpf(1.0f + __builtin_amdgcn_exp2f(-g * LOG2E)) * uu; }
__device__ __forceinline__ f32x4 silu_mul4(f32x4 g, f32x4 uu, float cg, float cu) {
    const f32x4 t = g * (-cg * LOG2E); f32x4 e;
    e[0] = __builtin_amdgcn_exp2f(t[0]); e[1] = __builtin_amdgcn_exp2f(t[1]); e[2] = __builtin_amdgcn_exp2f(t[2]); e[3] = __builtin_amdgcn_exp2f(t[3]);
    const f32x4 sden = e + 1.0f; f32x4 r;
    r[0] = __builtin_amdgcn_rcpf(sden[0]); r[1] = __builtin_amdgcn_rcpf(sden[1]); r[2] = __builtin_amdgcn_rcpf(sden[2]); r[3] = __builtin_amdgcn_rcpf(sden[3]);
    return (g * uu) * (r * (cg * cu));
}
__device__ __forceinline__ f32x4 silu_mul4_raw(f32x4 g, f32x4 uu, float kt) {
    const f32x4 t = g * kt; f32x4 e;
    e[0] = __builtin_amdgcn_exp2f(t[0]); e[1] = __builtin_amdgcn_exp2f(t[1]); e[2] = __builtin_amdgcn_exp2f(t[2]); e[3] = __builtin_amdgcn_exp2f(t[3]);
    const f32x4 sden = e + 1.0f; f32x4 r;
    r[0] = __builtin_amdgcn_rcpf(sden[0]); r[1] = __builtin_amdgcn_rcpf(sden[1]); r[2] = __builtin_amdgcn_rcpf(sden[2]); r[3] = __builtin_amdgcn_rcpf(sden[3]);
    return (g * uu) * r;
}
struct EpiGU {
    bf16_t* act; int ld;
    __device__ __forceinline__ void operator()(const Acc& acc, const Unit& u, int wr, int wc, int fr, int fq) const {
        const int c8 = wc * 32 + fq * 8; const int rbase = u.pm * 256;
        EPI_ROWS { const int row = rbase + EPI_RL; const f32x4 g0 = acc[ai][0][m][0], g1 = acc[ai][0][m][1], u0 = acc[ai][1][m][0], u1 = acc[ai][1][m][1]; f32x4 a0, a1;
            a0 = silu_mul4(g0, u0, 1.0f, 1.0f); a1 = silu_mul4(g1, u1, 1.0f, 1.0f);
            if (FP8_EMU) { a0 = q8v(a0, 4.f); a1 = q8v(a1, 4.f); }
            *(u32x4*)(act + (size_t)row * ld + u.pn * 128 + c8) = pack8(a0, a1); }
    }
};
struct EpiGU8 {
    unsigned char* act; const volatile LAS int* mt;
    __device__ __forceinline__ void operator()(const Acc& acc, const Unit& u, int wr, int wc, int fr, int fq) const {
        const int c8 = wc * 32 + fq * 8; const int rbase = __builtin_amdgcn_readfirstlane(mt[32 + u.e]) + u.pm * 256; constexpr float IS = 1.0f / (SX8 * SWGU8);
        EPI_ROWS { const int row = rbase + EPI_RL;
            const f32x4 a0 = silu_mul4_raw(acc[ai][0][m][0], acc[ai][1][m][0], -IS * LOG2E), a1 = silu_mul4_raw(acc[ai][0][m][1], acc[ai][1][m][1], -IS * LOG2E);
            constexpr float OS = 1.0f / (IS * IS * SACT8);
            u32x2 o; o.x = pack4_fp8_sc(a0[0], a0[1], a0[2], a0[3], OS); o.y = pack4_fp8_sc(a1[0], a1[1], a1[2], a1[3], OS);
            *(u32x2*)(act + (size_t)row * FE + u.pn * 128 + c8) = o; }
    }
};
struct EpiF32 { float* C;
    __device__ __forceinline__ void operator()(const Acc& acc, const Unit& u, int wr, int wc, int fr, int fq) const {
        const int c8 = wc * 32 + fq * 8;
        EPI_ROWS { const int row = u.pm * 256 + EPI_RL;
#pragma unroll
            for (int bj = 0; bj < 2; ++bj) { float* p = C + (size_t)row * DM + u.pn * 256 + bj * 128 + c8; *(f32x4*)p = acc[ai][bj][m][0]; *(f32x4*)(p + 4) = acc[ai][bj][m][1]; } }
    }
};
struct EpiBf { bf16_t* C;
    __device__ __forceinline__ void operator()(const Acc& acc, const Unit& u, int wr, int wc, int fr, int fq) const {
        const int c8 = wc * 32 + fq * 8;
        EPI_ROWS { const int row = u.pm * 256 + EPI_RL;
#pragma unroll
            for (int bj = 0; bj < 2; ++bj) *(u32x4*)(C + (size_t)row * DM + u.pn * 256 + bj * 128 + c8) = pack8(acc[ai][bj][m][0], acc[ai][bj][m][1]); }
    }
};
struct EpiMoeDown { bf16_t* ym; bf16_t* yx; const int* rinfo;
    __device__ __forceinline__ void operator()(const Acc& acc, const Unit& u, int wr, int wc, int fr, int fq) const {
        const int c8 = wc * 32 + fq * 8;
        EPI_ROWS { const int rl = EPI_RL;
            if (rl < u.nvalid) { bf16_t* p;
                if (u.ks == 0) { const int info = rinfo[u.e * CAP + u.pm * 256 + rl]; const int tok = info >> 1, k = info & 1; p = ym + ((size_t)k * SEQ + tok) * DM + u.pn * 256 + c8; }
                else p = yx + ((size_t)(u.ks - 1) * OVF_ROWS + u.aux * 256 + rl) * DM + u.pn * 256 + c8;
#pragma unroll
                for (int bj = 0; bj < 2; ++bj) *(u32x4*)(p + bj * 128) = pack8(acc[ai][bj][m][0] * (1.0f / (SACT8 * SWDN8)), acc[ai][bj][m][1] * (1.0f / (SACT8 * SWDN8))); } }
    }
};
}

#define XB_TMO      128
#define XB_XCNT(j)  (256  + 64 * (j))
#define XB_XSUB(j)  (1280 + 64 * (j))
#define XB_XGEN(j)  (2304 + 64 * (j))
#define XB_TOP      3328
#define XB_TOPGEN   3392
#define XCD_BAR_WORDS 3456
#define XB_SPIN_CAP (1u << 24)
__device__ __forceinline__ unsigned xb_ld(unsigned* p)              { return __hip_atomic_load(p, __ATOMIC_RELAXED, __HIP_MEMORY_SCOPE_AGENT); }
__device__ __forceinline__ unsigned xb_add(unsigned* p, unsigned v) { return __hip_atomic_fetch_add(p, v, __ATOMIC_RELAXED, __HIP_MEMORY_SCOPE_AGENT); }
__device__ __forceinline__ unsigned xb_xcc_id() { return (unsigned)__builtin_amdgcn_s_getreg((3 << 11) | 20) & 0xFu; }
#define XB_SPIN(cond, bar) do { unsigned _sp = 0; while (cond) { __builtin_amdgcn_s_sleep(1); \
    if ((++_sp & 255u) == 0u) { if (xb_ld(&(bar)[XB_TMO])) break; if (_sp > XB_SPIN_CAP) { atomicAdd(&(bar)[XB_TMO], 1u); break; } } } } while (0)
struct XcdBarrier { unsigned* bar; unsigned x; volatile LAS unsigned* st; };
__device__ __forceinline__ XcdBarrier xcd_barrier_post(unsigned* bar, volatile LAS unsigned* st) {
    XcdBarrier b; b.bar = bar; b.x = xb_xcc_id(); b.st = st;
    if (threadIdx.x == 0) (void)xb_add(&bar[XB_XCNT(b.x)], 1u);
    return b;
}
__device__ __forceinline__ void xcd_barrier_complete(unsigned* bar, unsigned x, unsigned& nloc, unsigned& nx) {
    const unsigned G = gridDim.x * gridDim.y * gridDim.z;
    unsigned sum, cnt, mine, sp = 0u;
    for (;;) {
        sum = 0u; cnt = 0u; mine = 0u;
#pragma unroll
        for (unsigned j = 0; j < 16; ++j) { const unsigned c = xb_ld(&bar[XB_XCNT(j)]); sum += c; cnt += (c > 0u) ? 1u : 0u; mine = (j == x) ? c : mine; }
        if (sum == G) break;
        __builtin_amdgcn_s_sleep(1);
        if ((++sp & 255u) == 0u) { if (xb_ld(&bar[XB_TMO])) break; if (sp > XB_SPIN_CAP) { atomicAdd(&bar[XB_TMO], 1u); break; } }
    }
    nloc = mine > 0u ? mine : 1u; nx = cnt > 0u ? cnt : 1u;
}
__device__ __forceinline__ void xcd_barrier(const XcdBarrier& b) {
    asm volatile("s_waitcnt vmcnt(0)" ::: "memory");
    __syncthreads();
    if (threadIdx.x == 0) {
        unsigned* bar = b.bar;
        __builtin_amdgcn_s_waitcnt(0);
        unsigned nloc = b.st[0], nx = b.st[1];
        if (nloc == 0u) { xcd_barrier_complete(bar, b.x, nloc, nx); b.st[0] = nloc; b.st[1] = nx; }
        const unsigned old = xb_add(&bar[XB_XSUB(b.x)], 1u);
        const unsigned gen = old / nloc;
        if (old + 1u == (gen + 1u) * nloc) {
            __builtin_amdgcn_fence(__ATOMIC_RELEASE, "agent");
            asm volatile("s_waitcnt vmcnt(0)" ::: "memory");
            const unsigned og = xb_add(&bar[XB_TOP], 1u);
            const unsigned tg = og / nx;
            if (og + 1u == (tg + 1u) * nx) xb_add(&bar[XB_TOPGEN], 1u);
            else XB_SPIN(xb_ld(&bar[XB_TOPGEN]) == tg, bar);
            __builtin_amdgcn_fence(__ATOMIC_ACQUIRE, "agent");
            xb_add(&bar[XB_XGEN(b.x)], 1u);
            asm volatile("s_waitcnt vmcnt(0)" ::: "memory");
        } else {
            XB_SPIN(xb_ld(&bar[XB_XGEN(b.x)]) == gen, bar);
            __builtin_amdgcn_fence(__ATOMIC_ACQUIRE, "agent");
            asm volatile("s_waitcnt vmcnt(0)" ::: "memory");
        }
    }
    __syncthreads();
}

struct Args { const float* in[25]; float* out; unsigned char* ws; int ph_lo, ph_hi; };
enum { I_X = 0, I_META, I_WIN, I_FBIAS, I_QNORM, I_KVNORM, I_WUQ, I_WUKV, I_WOUT, I_PWIN, I_PWGRP, I_PSCALE, I_PWOUT, I_FGATE, I_FUP, I_FDOWN, I_MROUTER, I_MBROUTER,
       I_MGATE, I_MUP, I_MDOWN, I_LNMG, I_LNMB, I_LNFG, I_LNFB };
struct Frame {
    LAS unsigned char* lds; volatile LAS int* MISC; unsigned* ctl; unsigned char* ws;
    int tid, lane, wave, vcu, G;
};
constexpr int NPHASE = 17;

enum { TK_PLAIN = 0, TK_IN, TK_UQ, TK_UKV, TK_GU };
__device__ __forceinline__ int t_srccol(int kind, int n) {
    switch (kind) {
        case TK_IN: return n < 1024 ? n : (n < 4096 ? n + 64 : (n < 4160 ? n - 3072 : (n < 4168 ? n : -1)));
        case TK_UQ: { if (n < 1024) return (n >> 7) * 192 + (n & 127); const int mm = n - 1024, h = mm >> 6, jj = mm & 63, q8 = jj >> 3, i = jj & 7;
                      return h * 192 + 128 + (i < 4 ? 4 * q8 + i : 32 + 4 * q8 + i - 4); }
        case TK_UKV: { if (n < 1024) return (n >> 7) * 256 + (n & 127); const int mm = n - 1024; return (mm >> 7) * 256 + 128 + (mm & 127); }
        case TK_GU: { const int p = n >> 8, r = n & 255; return 128 * p + (r & 127); }
        default: return n;
    }
}
struct TD { const float* W; const float* W2; const float* ksc; const float* nsc; bf16_t* WT; int K, Nsrc, kind, k0, n0, fp8; float wsc, q8; };
__device__ __forceinline__ void t_load(const TD& d, int lane, f32x2 (&v)[32]) {
    const int nd = d.n0 + 2 * (lane & 31); const int sc = t_srccol(d.kind, nd);
    const float* Ws = (d.kind == TK_GU && (nd & 128)) ? d.W2 : d.W;
    const float* p = Ws + (size_t)(d.k0 + (lane >> 5)) * d.Nsrc + (sc >= 0 ? sc : 0);
#pragma unroll
    for (int i = 0; i < 32; ++i) { v[i] = (f32x2){0.f, 0.f}; if (sc >= 0) v[i] = *(const f32x2*)(p + (size_t)(2 * i) * d.Nsrc); }
}
__device__ __forceinline__ void t_to_lds(int lane, const f32x2 (&v)[32], LAS float* scr) {
#pragma unroll
    for (int i = 0; i < 32; ++i) { const int kk = 2 * i + (lane >> 5); scr[kk * 65 + 2 * (lane & 31)] = v[i].x; scr[kk * 65 + 2 * (lane & 31) + 1] = v[i].y; }
}
__device__ __forceinline__ void t_store(const TD& d, int lane, LAS float* scr) {
    const int c = lane & 7;
    f32x4 ks0 = (f32x4){1.f, 1.f, 1.f, 1.f}, ks1 = ks0; if (d.ksc) { ks0 = *(const f32x4*)(d.ksc + d.k0 + 8 * c); ks1 = *(const f32x4*)(d.ksc + d.k0 + 8 * c + 4); }
#pragma unroll
    for (int j = 0; j < 8; ++j) { const int n = (lane >> 3) + 8 * j; const LAS float* s = scr + (8 * c) * 65 + n; const float ns = d.nsc ? d.nsc[d.n0 + n] : 1.f;
        f32x4 x0 = (f32x4){s[0 * 65], s[1 * 65], s[2 * 65], s[3 * 65]} * ks0 * ns, x1 = (f32x4){s[4 * 65], s[5 * 65], s[6 * 65], s[7 * 65]} * ks1 * ns;
        if (FP8_EMU && d.q8 > 0.f) { x0 = q8v(x0, d.q8); x1 = q8v(x1, d.q8); }
        *(u32x4*)(d.WT + (size_t)(d.n0 + n) * d.K + d.k0 + 8 * c) = pack8(x0, x1); }
}
__device__ __forceinline__ void t_load8(const TD& d, int lane, f32x2 (&v)[32]) {
    const int nd = d.n0 + 2 * (lane & 15); const int sc = t_srccol(d.kind, nd);
    const float* Ws = (d.kind == TK_GU && (nd & 128)) ? d.W2 : d.W;
    const float* p = Ws + (size_t)(d.k0 + (lane >> 4)) * d.Nsrc + sc;
#pragma unroll
    for (int i = 0; i < 32; ++i) v[i] = *(const f32x2*)(p + (size_t)(4 * i) * d.Nsrc);
}
__device__ __forceinline__ void t_to_lds8(int lane, const f32x2 (&v)[32], LAS float* scr) {
#pragma unroll
    for (int i = 0; i < 32; ++i) { const int kk = 4 * i + (lane >> 4); scr[kk * 33 + 2 * (lane & 15)] = v[i].x; scr[kk * 33 + 2 * (lane & 15) + 1] = v[i].y; }
}
__device__ __forceinline__ void t_store8(const TD& d, int lane, LAS float* scr) {
    const int c = lane & 7; unsigned char* WT8 = (unsigned char*)d.WT; const float ws = d.wsc;
#pragma unroll
    for (int j = 0; j < 4; ++j) { const int n = (lane >> 3) + 8 * j; const LAS float* s = scr + (16 * c) * 33 + n;
        u32x4 o; o.x = pack4_fp8(s[0 * 33] * ws, s[1 * 33] * ws, s[2 * 33] * ws, s[3 * 33] * ws); o.y = pack4_fp8(s[4 * 33] * ws, s[5 * 33] * ws, s[6 * 33] * ws, s[7 * 33] * ws);
        o.z = pack4_fp8(s[8 * 33] * ws, s[9 * 33] * ws, s[10 * 33] * ws, s[11 * 33] * ws); o.w = pack4_fp8(s[12 * 33] * ws, s[13 * 33] * ws, s[14 * 33] * ws, s[15 * 33] * ws);
        *(u32x4*)(WT8 + (size_t)(d.n0 + n) * d.K + d.k0 + 16 * c) = o; }
}

constexpr int BG_PER_EXPERT = 32 * 448, BG_GU_ITEMS = 8 * BG_PER_EXPERT;
constexpr int BG_DN_PER_EXPERT = 112 * 64, BG_DN_ITEMS = 31360;
constexpr int BG_FGU_ITEMS = 32 * 352, BG_FDN_ITEMS = 88 * 64;
constexpr int BG_J1 = BG_GU_ITEMS + BG_DN_ITEMS, BG_J2 = BG_J1 + BG_FGU_ITEMS, BG_ITEMS = BG_J2 + BG_FDN_ITEMS;
__device__ __forceinline__ void bg_issue(const Args& a, int j, LAS unsigned char* scr, int lane) {
    const float* W; int ld;
    if (j < BG_GU_ITEMS) { const int e = j / BG_PER_EXPERT, r = j - e * BG_PER_EXPERT, kb = r / 448, nb = r - kb * 448, n0 = nb * 32, p = n0 >> 8, r0 = n0 & 255;
        W = ((r0 & 128) ? a.in[I_MUP] : a.in[I_MGATE]) + (size_t)e * 2048 * FE + (size_t)(kb * 64) * FE + 128 * p + (r0 & 127); ld = FE; }
    else if (j < BG_J1) { const int jj = j - BG_GU_ITEMS, e = jj / BG_DN_PER_EXPERT, r = jj - e * BG_DN_PER_EXPERT, kb = r >> 6, nb = r & 63;
        W = a.in[I_MDOWN] + (size_t)e * FE * 2048 + (size_t)(kb * 64) * 2048 + nb * 32; ld = 2048; }
    else if (j < BG_J2) { const int r = j - BG_J1, kb = r / 352, nb = r - kb * 352, n0 = nb * 32, p = n0 >> 8, r0 = n0 & 255;
        W = ((r0 & 128) ? a.in[I_FUP] : a.in[I_FGATE]) + (size_t)(kb * 64) * FFN + 128 * p + (r0 & 127); ld = FFN; }
    else { const int r = j - BG_J2, kb = r >> 6, nb = r & 63; W = a.in[I_FDOWN] + (size_t)(kb * 64) * 2048 + nb * 32; ld = 2048; }
    const unsigned loff = (unsigned)((lane >> 3) * ld + (lane & 7) * 4) * 4u;
#pragma unroll
    for (int p8 = 0; p8 < 8; ++p8) __builtin_amdgcn_global_load_lds((const unsigned*)((const char*)(W + (size_t)(8 * p8) * ld) + loff), (LAS unsigned*)(scr + p8 * 1024), 16, 0, 0);
}
__device__ __forceinline__ void bg_flush(unsigned char* ws, int j, const LAS unsigned char* scr, int lane) {
    const int n = lane & 31, kh = lane >> 5; unsigned char* dst; float sc;
    if (j < BG_GU_ITEMS) { const int e = j / BG_PER_EXPERT, r = j - e * BG_PER_EXPERT, kb = r / 448, nb = r - kb * 448;
        dst = ws + WS_W_MGU + (size_t)e * 2 * FE * 2048 + (size_t)(nb * 32 + n) * 2048 + kb * 64 + 32 * kh; sc = 1.f / SWGU8; }
    else if (j < BG_J1) { const int jj = j - BG_GU_ITEMS, e = jj / BG_DN_PER_EXPERT, r = jj - e * BG_DN_PER_EXPERT, kb = r >> 6, nb = r & 63;
        dst = ws + WS_W_MDN + (size_t)e * 2048 * FE + (size_t)(nb * 32 + n) * FE + kb * 64 + 32 * kh; sc = 1.f / SWDN8; }
    else { const LAS float* s = (const LAS float*)scr + (32 * kh) * 32 + n;
        if (j < BG_J2) { const int r = j - BG_J1, kb = r / 352, nb = r - kb * 352; dst = ws + WS_W_GU + ((size_t)(nb * 32 + n) * 2048 + kb * 64 + 32 * kh) * 2; }
        else { const int r = j - BG_J2, kb = r >> 6, nb = r & 63; dst = ws + WS_W_DN + ((size_t)(nb * 32 + n) * FFN + kb * 64 + 32 * kh) * 2; }
#pragma unroll
        for (int h = 0; h < 4; ++h) { const f32x4 x0 = (f32x4){s[(8 * h + 0) * 32], s[(8 * h + 1) * 32], s[(8 * h + 2) * 32], s[(8 * h + 3) * 32]}, x1 = (f32x4){s[(8 * h + 4) * 32], s[(8 * h + 5) * 32], s[(8 * h + 6) * 32], s[(8 * h + 7) * 32]};
            *(u32x4*)(dst + 16 * h) = pack8(x0, x1); }
        return; }
    const LAS float* s = (const LAS float*)scr + (32 * kh) * 32 + n;
#pragma unroll
    for (int h = 0; h < 2; ++h) { u32x4 o;
        o.x = pack4_fp8_sc(s[(16 * h + 0) * 32], s[(16 * h + 1) * 32], s[(16 * h + 2) * 32], s[(16 * h + 3) * 32], sc);
        o.y = pack4_fp8_sc(s[(16 * h + 4) * 32], s[(16 * h + 5) * 32], s[(16 * h + 6) * 32], s[(16 * h + 7) * 32], sc);
        o.z = pack4_fp8_sc(s[(16 * h + 8) * 32], s[(16 * h + 9) * 32], s[(16 * h + 10) * 32], s[(16 * h + 11) * 32], sc);
        o.w = pack4_fp8_sc(s[(16 * h + 12) * 32], s[(16 * h + 13) * 32], s[(16 * h + 14) * 32], s[(16 * h + 15) * 32], sc);
        *(u32x4*)(dst + 16 * h) = o; }
}
__device__ __forceinline__ void sincos_d(double x, double& s, double& c) {
    const double kd = rint(x * 0.63661977236758134308); const double r = (x - kd * 1.57079632673412561417e+00) - kd * 6.07710050650619224932e-11; const double r2 = r * r;
    double sp = -7.6471637318198164759e-13; sp = sp * r2 + 1.6059043836821614599e-10; sp = sp * r2 - 2.5052108385441718775e-08; sp = sp * r2 + 2.7557319223985890653e-06;
    sp = sp * r2 - 1.9841269841269841270e-04; sp = sp * r2 + 8.3333333333333333333e-03; sp = sp * r2 - 1.6666666666666666667e-01; const double sr = r + r * r2 * sp;
    double cp = 4.7794773323873852974e-14; cp = cp * r2 - 1.1470745597729724714e-11; cp = cp * r2 + 2.0876756987868098979e-09; cp = cp * r2 - 2.7557319223985890653e-07;
    cp = cp * r2 + 2.4801587301587301587e-05; cp = cp * r2 - 1.3888888888888888889e-03; cp = cp * r2 + 4.1666666666666666667e-02; cp = cp * r2 - 0.5; const double cr = 1.0 + r2 * cp;
    const int q = ((int)kd) & 3;
    s = (q == 0) ? sr : (q == 1) ? cr : (q == 2) ? -sr : -cr; c = (q == 0) ? cr : (q == 1) ? -sr : (q == 2) ? -cr : sr;
}
constexpr int I0 = 32 * 68, I1 = I0 + 8 * 24, I2 = I1 + 8 * 32, I3 = I2 + 1024, I4 = I3 + 32 * 176, I5 = I4 + 88 * 32, I6 = I5 + 1024, I7 = I6 + 4 * 64, I8 = I7 + 1024,
              I9 = I8 + 8 * 32 * 224, I10 = I9 + 8 * 112 * 32;
#ifndef TAIL_ITEMS_1
#define TAIL_ITEMS_1 8992
#endif
#ifndef TAIL_ITEMS_2
#define TAIL_ITEMS_2 4000
#endif
constexpr int I_B = I10 - TAIL_ITEMS_2, I_A = I_B - TAIL_ITEMS_1;
static_assert((I_A - I9) % 64 == 0 && BG_DN_ITEMS == 2 * (I_A - I9), "the background down-weight items are exactly the prologue-form items [I9, I_A)");
__device__ __forceinline__ void convert_range(Frame& F, const Args& a, int begin, int end, int w, int nw) {
    LAS float* scr = (LAS float*)(F.lds + F.wave * 16896);
    unsigned char* ws = F.ws;
    auto decode = [&](int it, TD& d) {
        const float* W; const float* W2 = nullptr; const float* ksc = nullptr; const float* nsc = nullptr; bf16_t* WT; int K, Nsrc, Ndst, kind = TK_PLAIN, item;
        if (it < I0) { W = a.in[I_WIN]; K = 2048; Nsrc = 4168; Ndst = NIN; kind = TK_IN; WT = (bf16_t*)(ws + WS_W_IN); item = it; }
        else if (it < I1) { W = a.in[I_WUQ]; K = 512; Nsrc = 1536; Ndst = 1536; kind = TK_UQ; ksc = a.in[I_QNORM]; WT = (bf16_t*)(ws + WS_W_UP); item = it - I0; }
        else if (it < I2) { W = a.in[I_WUKV]; K = 512; Nsrc = 2048; Ndst = 2048; kind = TK_UKV; ksc = a.in[I_KVNORM]; WT = (bf16_t*)(ws + WS_W_UP) + (size_t)1536 * 512; item = it - I1; }
        else if (it < I3) { W = a.in[I_WOUT]; K = 2048; Nsrc = 2048; Ndst = 2048; WT = (bf16_t*)(ws + WS_W_OUT); item = it - I2; }
        else if (it < I4) { W = a.in[I_FGATE]; W2 = a.in[I_FUP]; K = 2048; Nsrc = FFN; Ndst = 2 * FFN; kind = TK_GU; WT = (bf16_t*)(ws + WS_W_GU); item = it - I3; }
        else if (it < I5) { W = a.in[I_FDOWN]; K = FFN; Nsrc = 2048; Ndst = 2048; WT = (bf16_t*)(ws + WS_W_DN); item = it - I4; }
        else if (it < I6) { W = a.in[I_PWIN]; K = 2048; Nsrc = 2048; Ndst = 2048; ksc = a.in[I_LNFG]; WT = (bf16_t*)(ws + WS_W_PIN); item = it - I5; }
        else if (it < I7) { const int r = it - I6, g = r >> 6; W = a.in[I_PWGRP] + (size_t)g * 512 * 512; K = 512; Nsrc = 512; Ndst = 512; nsc = a.in[I_PSCALE] + g * 512; WT = (bf16_t*)(ws + WS_W_GRP) + (size_t)g * 512 * 512; item = r & 63; }
        else if (it < I8) { W = a.in[I_PWOUT]; K = 2048; Nsrc = 2048; Ndst = 2048; WT = (bf16_t*)(ws + WS_W_POUT); item = it - I7; }
        else if (it < I9) { const int r = it - I8, e = r / (32 * 224); W = a.in[I_MGATE] + (size_t)e * 2048 * FE; W2 = a.in[I_MUP] + (size_t)e * 2048 * FE; K = 2048; Nsrc = FE; Ndst = 2 * FE; kind = TK_GU; WT = (bf16_t*)(ws + WS_W_MGU + (size_t)e * 2 * FE * 2048); item = r % (32 * 224); }
        else { const int r = it - I9, e = r / (112 * 32); W = a.in[I_MDOWN] + (size_t)e * FE * 2048; K = FE; Nsrc = 2048; Ndst = 2048; WT = (bf16_t*)(ws + WS_W_MDN + (size_t)e * 2048 * FE); item = r % (112 * 32); }
        const int f8 = it >= I8 ? 1 : 0; const int nblk = f8 ? Ndst / 32 : Ndst / 64;
        d.q8 = (it >= I3 && it < I4) ? 512.f : ((it >= I4 && it < I5) ? 2048.f : 0.f); d.fp8 = f8; d.wsc = it >= I9 ? SWDN8 : SWGU8; d.W = W; d.W2 = W2; d.ksc = ksc; d.nsc = nsc; d.WT = WT; d.K = K; d.Nsrc = Nsrc; d.kind = kind;
        d.k0 = f8 ? 128 * (item / nblk) : 64 * (item / nblk); d.n0 = f8 ? 32 * (item % nblk) : 64 * (item % nblk);
    };
    TD cur, nxt; f32x2 v[32]; int it = begin + w;
    if (it < end) { decode(it, cur); if (cur.fp8) t_load8(cur, F.lane, v); else t_load(cur, F.lane, v); }
    while (it < end) {
        if (cur.fp8) t_to_lds8(F.lane, v, scr); else t_to_lds(F.lane, v, scr);
        const int itn = it + nw;
        if (itn < end) { decode(itn, nxt); if (nxt.fp8) t_load8(nxt, F.lane, v); else t_load(nxt, F.lane, v); }
        LDS_WAIT(); asm volatile("" ::: "memory");
        if (cur.fp8) t_store8(cur, F.lane, scr); else t_store(cur, F.lane, scr);
        LDS_WAIT(); asm volatile("" ::: "memory");
        cur = nxt; it = itn;
    }
}
__device__ __forceinline__ void p0_prologue(Frame& F, const Args& a) {
    const int gw = F.vcu * 8 + F.wave, NGW = F.G * 8;
    unsigned char* ws = F.ws;
#if BG_IN_ATTN
    convert_range(F, a, 0, I3, gw, NGW);
    convert_range(F, a, I5, I8, gw, NGW);
    if (F.G != 256) convert_range(F, a, I_A, I10, gw, NGW);
#elif BG_IN_PROLOGUE
    convert_range(F, a, 0, I8, gw, NGW);
    convert_range(F, a, I9, F.G == 256 ? I_A : I10, gw, NGW);
    { LAS unsigned char* bscr = F.lds + F.wave * 16896;
      for (int j = gw; j < BG_GU_ITEMS; j += NGW) { bg_issue(a, j, bscr, F.lane); VM_WAIT(); asm volatile("" ::: "memory"); bg_flush(ws, j, bscr, F.lane); LDS_WAIT(); asm volatile("" ::: "memory"); } }
#else
    convert_range(F, a, 0, F.G == 256 ? I_A : I10, gw, NGW);
#endif
    { float* cs = (float*)(ws + WS_CS); const int gt = (F.vcu * 8 + F.wave) * 64 + F.lane, NT = F.G * 512;
      for (int i = gt; i < R * 32; i += NT) { const int row = i >> 5, j = i & 31; const int pos = row >= PADR ? row - PADR : 0;
          const float ang = (float)pos * INV_FREQ[j]; double s, c; sincos_d((double)ang, s, c); cs[(size_t)row * 64 + j] = (float)c; cs[(size_t)row * 64 + 32 + j] = (float)s; } }
    { bf16_t* hb = (bf16_t*)(ws + WS_L_H0B);
      for (int row = gw; row < R; row += NGW) { const float* src = row >= ROW0 ? a.in[I_X] + (size_t)(row - ROW0) * DM : (row >= PADR ? a.in[I_META] + (size_t)(row - PADR) * DM : nullptr);
#pragma unroll
          for (int j = 0; j < 4; ++j) { const int col = 8 * F.lane + 512 * j; f32x4 v0 = (f32x4){0.f, 0.f, 0.f, 0.f}, v1 = v0; if (src) { v0 = *(const f32x4*)(src + col); v1 = *(const f32x4*)(src + col + 4); }
              *(u32x4*)(hb + (size_t)row * DM + col) = pack8(v0, v1); } } }
}

__device__ __forceinline__ void p2_ext(Frame& F) {
    unsigned char* ws = F.ws; const float* lf = (const float*)(ws + WS_L_LF); const float* kr = (const float*)(ws + WS_L_KR); const float* cs = (const float*)(ws + WS_CS);
    bf16_t* qp = (bf16_t*)(ws + WS_L_QP); bf16_t* kp = (bf16_t*)(ws + WS_L_KP);
    LAS double* red = (LAS double*)(F.lds);
    const int CH = (LTOK + F.G - 1) / F.G;
    for (int ch = blockIdx.x; ch * CH < LTOK; ch += F.G) {
        const int p0 = ch * CH, p1 = (p0 + CH < LTOK) ? p0 + CH : LTOK;
        double accd[8];
#pragma unroll
        for (int h = 0; h < 8; ++h) accd[h] = 0.0;
        for (int p = F.tid; p < p0; p += 512) { const f32x4 a0 = *(const f32x4*)(lf + (size_t)(PADR + p) * 8), a1 = *(const f32x4*)(lf + (size_t)(PADR + p) * 8 + 4);
#pragma unroll
            for (int h = 0; h < 4; ++h) { accd[h] += (double)a0[h]; accd[4 + h] += (double)a1[h]; } }
#pragma unroll
        for (int h = 0; h < 8; ++h) { const double s = wave_sum_d(accd[h]); if (F.lane == 0) red[F.wave * 8 + h] = s; }
        __syncthreads();
        if (F.tid < 8) { double s = 0.0; for (int w = 0; w < 8; ++w) s += red[w * 8 + F.tid]; red[64 + F.tid] = s; }
        __syncthreads();
        const int nrow = p1 - p0;
        if (F.tid < nrow * 8) { const int r = F.tid >> 3, h = F.tid & 7; double c = red[64 + h];
            for (int i = 0; i <= r; ++i) c += (double)lf[(size_t)(PADR + p0 + i) * 8 + h];
            const float cf = (float)(c * 1.4426950408889634074);
            const float hi = bf2f(f2bf(cf)), r1 = cf - hi, mid = bf2f(f2bf(r1)), r2 = r1 - mid, lo = bf2f(f2bf(r2));
            const int pos = p0 + r, row = PADR + pos;
            u32x4 z = (u32x4){0u, 0u, 0u, 0u};
            u32x4 q0; q0.x = cvt_pk_bf16(hi, mid); q0.y = cvt_pk_bf16(lo, 1.f); q0.z = cvt_pk_bf16(1.f, 1.f); q0.w = 0u;
            u32x4 k0 = z; if (pos >= NMETA) { k0.x = cvt_pk_bf16(1.f, 1.f); k0.y = cvt_pk_bf16(1.f, -hi); k0.z = cvt_pk_bf16(-mid, -lo); }
            u32x4* qd = (u32x4*)(qp + ((size_t)(8 + h) * R + row) * DKP + 128); u32x4* kd = (u32x4*)(kp + ((size_t)(8 + h) * R + row) * DKP + 128);
            qd[0] = q0; kd[0] = k0;
#pragma unroll
            for (int j = 1; j < 8; ++j) { qd[j] = z; kd[j] = z; }
        }
        for (int i = F.tid; i < nrow * 32; i += 512) { const int r = i >> 5, j = i & 31, row = PADR + p0 + r;
            const float x1 = kr[(size_t)row * 64 + j], x2 = kr[(size_t)row * 64 + 32 + j], c = cs[(size_t)row * 64 + j], s = cs[(size_t)row * 64 + 32 + j];
            const bf16_t o1 = f2bf(x1 * c - x2 * s), o2 = f2bf(x2 * c + x1 * s);
#pragma unroll
            for (int h = 0; h < 8; ++h) { bf16_t* k = kp + ((size_t)h * R + row) * DKP + 128; k[j] = o1; k[32 + j] = o2; } }
        __syncthreads();
    }
}

__device__ __forceinline__ void p3_attn_naive(Frame& F) {
    unsigned char* ws = F.ws; const bf16_t* QP = (const bf16_t*)(ws + WS_L_QP); const bf16_t* KP = (const bf16_t*)(ws + WS_L_KP); const bf16_t* VP = (const bf16_t*)(ws + WS_L_VP);
    bf16_t* O = (bf16_t*)(ws + WS_L_O);
    LAS float* qs = (LAS float*)(F.lds + F.wave * 1024);
    const int gw = F.vcu * 8 + F.wave, NGW = F.G * 8, lane = F.lane;
    for (int t = gw; t < NH * LTOK; t += NGW) {
        const int head = t / LTOK, pos = t % LTOK, row = pos + PADR;
        const bf16_t* q = QP + ((size_t)head * R + row) * DKP;
        LDS_WAIT();
        for (int d = lane; d < DKP; d += 64) qs[d] = bf2f(q[d]);
        LDS_WAIT(); asm volatile("" ::: "memory");
        float mrun = -1e30f, l = 0.f, o0 = 0.f, o1 = 0.f; const int nk = pos + 1;
        for (int k0 = 0; k0 < nk; k0 += 64) {
            const int kpos = k0 + lane; float s = -__builtin_inff();
            if (kpos < nk) { const u32x4* kr = (const u32x4*)(KP + ((size_t)head * R + PADR + kpos) * DKP); float a = 0.f;
#pragma unroll 4
                for (int c = 0; c < 24; ++c) { const u32x4 kv = kr[c];
                    a += qs[c * 8 + 0] * bf_lo(kv.x) + qs[c * 8 + 1] * bf_hi(kv.x) + qs[c * 8 + 2] * bf_lo(kv.y) + qs[c * 8 + 3] * bf_hi(kv.y)
                       + qs[c * 8 + 4] * bf_lo(kv.z) + qs[c * 8 + 5] * bf_hi(kv.z) + qs[c * 8 + 6] * bf_lo(kv.w) + qs[c * 8 + 7] * bf_hi(kv.w); }
                s = a; }
            const float mn = fmaxf(mrun, wave_max(s)); const float alpha = __builtin_amdgcn_exp2f(mrun - mn); const float p = __builtin_amdgcn_exp2f(s - mn);
            l = l * alpha + wave_sum(p); o0 *= alpha; o1 *= alpha; mrun = mn;
            const int kn = (nk - k0) < 64 ? (nk - k0) : 64;
            for (int j = 0; j < kn; ++j) { const float pj = __shfl(p, j); const unsigned vv = *(const unsigned*)(VP + ((size_t)head * R + PADR + k0 + j) * DV + 2 * lane);
                o0 += pj * bf_lo(vv); o1 += pj * bf_hi(vv); }
        }
        const float il = 1.0f / l;
        *(unsigned*)(O + (size_t)row * DM + head * DV + 2 * lane) = cvt_pk_bf16(o0 * il, o1 * il);
    }
}


namespace att {
typedef float f32x16 __attribute__((ext_vector_type(16)));
typedef short s16x4 __attribute__((ext_vector_type(4)));
typedef LAS char* lptr; typedef const LAS char* lcptr;
constexpr int KVBLK = 64, KROW = 400, SHM_K = KVBLK * KROW, SHM_V = KVBLK * DV * 2;
constexpr int OFF_V = 0, OFF_K = 2 * SHM_V, OFF_WS = OFF_K + 2 * SHM_K, LDS_NEED = OFF_WS + 8 * 64 * 4;
constexpr float THR2 = 11.5f;
#define AT_KSWZ(row, colB) ((row) * KROW + (colB))
#define AT_SBAR() __builtin_amdgcn_sched_barrier(0)
__device__ __forceinline__ int v_st(int k, int c) { const int kk = (k & ~0xC) | ((k & 4) << 1) | ((k & 8) >> 1); return ((kk >> 3) * 4 + (c >> 5)) * 512 + ((kk & 7) * 32 + (c & 31)) * 2; }
__device__ __forceinline__ int v_rd_base(int lane) { return ((lane & 3) << 3) | (((lane >> 2) & 3) << 6) | (((lane >> 4) & 1) << 5) | (((lane >> 5) & 1) << 8); }
constexpr int v_rd_off(int d0, int ks, int half) { return d0 * 512 + ks * 4096 + half * 2048; }
__device__ __forceinline__ int crow(int r, int hi) { return (r & 3) + 8 * (r >> 2) + 4 * hi; }
__device__ __forceinline__ void mask_causal(f32x16& p0, f32x16& p1, int dq) {
    const float NEG = -__builtin_inff();
#pragma unroll
    for (int r = 0; r < 16; ++r) { const int c = (r & 3) + 8 * (r >> 2); if (dq - c < 0) p0[r] = NEG; if (dq - c - 32 < 0) p1[r] = NEG; }
}
__device__ __forceinline__ void mask_pad(f32x16& p0, f32x16& p1) {
    const float NEG = -__builtin_inff();
#pragma unroll
    for (int r = 0; r < 16; ++r) { p0[r] = NEG; if (r < 8) p1[r] = NEG; }
}
__device__ __forceinline__ void partialSM(f32x16& p0, f32x16& p1, float& m_reg, float& mn, float& alpha) {
    float pmax = p0[0];
#pragma unroll
    for (int r = 1; r < 16; ++r) pmax = fmaxf(pmax, p0[r]);
#pragma unroll
    for (int r = 0; r < 16; ++r) pmax = fmaxf(pmax, p1[r]);
    { auto rr = __builtin_amdgcn_permlane32_swap(__float_as_uint(pmax), __float_as_uint(pmax), false, false);
      pmax = fmaxf(__uint_as_float(rr[0]), __uint_as_float(rr[1])); }
    if (__builtin_expect(__all((pmax - m_reg) <= THR2), 1)) { mn = m_reg; alpha = 1.f; }
    else { mn = fmaxf(m_reg, pmax); alpha = __builtin_amdgcn_exp2f(m_reg - mn); m_reg = mn; }
#pragma unroll
    for (int r = 0; r < 16; ++r) p0[r] = __builtin_amdgcn_exp2f(p0[r] - mn);
}
__device__ __forceinline__ void finishSM(f32x16& p0, f32x16& p1, float mn, float alpha, float& l_reg, bf16x8& pa0, bf16x8& pa1, bf16x8& pa2, bf16x8& pa3) {
#pragma unroll
    for (int r = 0; r < 16; ++r) p1[r] = __builtin_amdgcn_exp2f(p1[r] - mn);
    float ps = 0;
#pragma unroll
    for (int r = 0; r < 16; ++r) ps += p0[r];
#pragma unroll
    for (int r = 0; r < 16; ++r) ps += p1[r];
    { auto rr = __builtin_amdgcn_permlane32_swap(__float_as_uint(ps), __float_as_uint(ps), false, false);
      ps = __uint_as_float(rr[0]) + __uint_as_float(rr[1]); }
    l_reg = l_reg * alpha + ps;
#define AT_PK4(P, B_, OUT) do { unsigned a0 = cvt_pk_bf16(P[B_+0], P[B_+1]), a1 = cvt_pk_bf16(P[B_+2], P[B_+3]);                          \
        unsigned b0 = cvt_pk_bf16(P[B_+4], P[B_+5]), b1 = cvt_pk_bf16(P[B_+6], P[B_+7]);                                             \
        auto r0 = __builtin_amdgcn_permlane32_swap(a0, b0, false, false); auto r1 = __builtin_amdgcn_permlane32_swap(a1, b1, false, false); \
        u32x4 w = {r0[0], r1[0], r0[1], r1[1]}; OUT = __builtin_bit_cast(bf16x8, w); } while (0)
    AT_PK4(p0, 0, pa0); AT_PK4(p0, 8, pa1); AT_PK4(p1, 0, pa2); AT_PK4(p1, 8, pa3);
#undef AT_PK4
}
#define AT_LGK(n) asm volatile("s_waitcnt lgkmcnt(" #n ")" ::: "memory")
__device__ __forceinline__ void qkt(f32x16& p0, f32x16& p1, lcptr kbuf, int r32, int hi, const bf16x8* qr) {
    p0 = f32x16{}; p1 = f32x16{};
    const unsigned kb = (unsigned)(size_t)kbuf + (unsigned)AT_KSWZ(r32, hi * 16);
    bf16x8 fa0, fa1, fb0, fb1, fc0, fc1;
#define QK_RD(dst, off) asm volatile("ds_read_b128 %0, %1 offset:%2" : "=&v"(dst) : "v"(kb), "i"(off) : "memory")
#define QK_LD(X, d0) do { QK_RD(X##0, 32 * (d0)); QK_RD(X##1, 32 * (d0) + 32 * KROW); } while (0)
#define QK_MM(X, d0) do { p0 = __builtin_amdgcn_mfma_f32_32x32x16_bf16(X##0, qr[d0], p0, 0, 0, 0); p1 = __builtin_amdgcn_mfma_f32_32x32x16_bf16(X##1, qr[d0], p1, 0, 0, 0); } while (0)
    QK_LD(fa, 0); QK_LD(fb, 1);
    QK_LD(fc, 2); AT_LGK(4); AT_SBAR(); QK_MM(fa, 0); AT_SBAR();
    QK_LD(fa, 3); AT_LGK(4); AT_SBAR(); QK_MM(fb, 1); AT_SBAR();
    QK_LD(fb, 4); AT_LGK(4); AT_SBAR(); QK_MM(fc, 2); AT_SBAR();
    QK_LD(fc, 5); AT_LGK(4); AT_SBAR(); QK_MM(fa, 3); AT_SBAR();
    QK_LD(fa, 6); AT_LGK(4); AT_SBAR(); QK_MM(fb, 4); AT_SBAR();
    QK_LD(fb, 7); AT_LGK(4); AT_SBAR(); QK_MM(fc, 5); AT_SBAR();
    QK_LD(fc, 8); AT_LGK(4); AT_SBAR(); QK_MM(fa, 6); AT_SBAR();
    QK_LD(fa, 9); AT_LGK(4); AT_SBAR(); QK_MM(fb, 7); AT_SBAR();
    QK_LD(fb, 10); AT_LGK(4); AT_SBAR(); QK_MM(fc, 8); AT_SBAR();
    QK_LD(fc, 11); AT_LGK(4); AT_SBAR(); QK_MM(fa, 9); AT_SBAR();
    AT_LGK(2); AT_SBAR(); QK_MM(fb, 10); AT_SBAR();
    AT_LGK(0); AT_SBAR(); QK_MM(fc, 11);
#undef QK_RD
#undef QK_LD
#undef QK_MM
}
template <int VB>
__device__ __forceinline__ void pv_tile(f32x16* o, unsigned vb0, bf16x8 pa0, bf16x8 pa1, bf16x8 pa2, bf16x8 pa3) {
    s16x4 al0, ah0, al1, ah1, al2, ah2, al3, ah3, bl0, bh0, bl1, bh1, bl2, bh2, bl3, bh3;
#define AT_TRRD(dst, off) asm volatile("ds_read_b64_tr_b16 %0, %1 offset:%2" : "=&v"(dst) : "v"(vb0), "i"(off) : "memory")
#define PV_RDA(S, d0) do { constexpr int b_ = VB * SHM_V + v_rd_off(d0, 0, 0); AT_TRRD(S##l0, b_); AT_TRRD(S##h0, b_ + 2048); AT_TRRD(S##l1, b_ + 4096); AT_TRRD(S##h1, b_ + 6144); } while (0)
#define PV_RDB(S, d0) do { constexpr int b_ = VB * SHM_V + v_rd_off(d0, 0, 0); AT_TRRD(S##l2, b_ + 8192); AT_TRRD(S##h2, b_ + 10240); AT_TRRD(S##l3, b_ + 12288); AT_TRRD(S##h3, b_ + 14336); } while (0)
#define PV_MM(d0, pa, L, H) do { AT_SBAR(); o[d0] = __builtin_amdgcn_mfma_f32_32x32x16_bf16(pa, (bf16x8){L[0], L[1], L[2], L[3], H[0], H[1], H[2], H[3]}, o[d0], 0, 0, 0); AT_SBAR(); } while (0)
    PV_RDA(a, 0); PV_RDB(a, 0);
    PV_RDA(b, 1); AT_LGK(10); PV_MM(0, pa0, al0, ah0); AT_LGK(8); PV_MM(0, pa1, al1, ah1);
    PV_RDB(b, 1); AT_LGK(10); PV_MM(0, pa2, al2, ah2); AT_LGK(8); PV_MM(0, pa3, al3, ah3);
    PV_RDA(a, 2); AT_LGK(10); PV_MM(1, pa0, bl0, bh0); AT_LGK(8); PV_MM(1, pa1, bl1, bh1);
    PV_RDB(a, 2); AT_LGK(10); PV_MM(1, pa2, bl2, bh2); AT_LGK(8); PV_MM(1, pa3, bl3, bh3);
    PV_RDA(b, 3); AT_LGK(10); PV_MM(2, pa0, al0, ah0); AT_LGK(8); PV_MM(2, pa1, al1, ah1);
    PV_RDB(b, 3); AT_LGK(10); PV_MM(2, pa2, al2, ah2); AT_LGK(8); PV_MM(2, pa3, al3, ah3);
    AT_LGK(6); PV_MM(3, pa0, bl0, bh0); AT_LGK(4); PV_MM(3, pa1, bl1, bh1); AT_LGK(2); PV_MM(3, pa2, bl2, bh2); AT_LGK(0); PV_MM(3, pa3, bl3, bh3);
#undef PV_RDA
#undef PV_RDB
#undef PV_MM
#undef AT_TRRD
}
__device__ __forceinline__ void attn_block(const bf16_t* Qh, const bf16_t* Kh, const bf16_t* Vh, bf16_t* Oh, int b, bool rev, lptr lds, const Args& bga, unsigned char* bgws, int& bgt, int& bgk, int& bgp, int bgw, int bgn) {
    const int tid = threadIdx.x, wid = __builtin_amdgcn_readfirstlane(tid >> 6), lane = tid & 63, r32 = lane & 31, hi = lane >> 5;
    const int j_lo = 3, NT = 4 * b + 1;
    lptr V_lds = lds + OFF_V; lptr K_lds = lds + OFF_K;
    LAS float* wsf = (LAS float*)(lds + OFF_WS) + wid * 64; LAS float* li_l = wsf; LAS float* al_l = wsf + 32;
    LAS unsigned char* bscr = (LAS unsigned char*)(lds + LDS_NEED) + wid * 8192;
    const int qlo = 256 * b + wid * 32, qrow = qlo + r32;
    unsigned koff[3], voff[2];
#pragma unroll
    for (int i = 0; i < 3; ++i) { const int g = (wid + 8 * i) * 64 + lane, row = g / 25, cp = g - row * 25; koff[i] = (unsigned)(row * 384 + (cp < 24 ? cp : 0) * 16); }
    unsigned koff3; { const int g = 24 * 64 + lane, row = g / 25, cp = g - row * 25; koff3 = (unsigned)(row * 384 + (cp < 24 ? cp : 0) * 16); }
#pragma unroll
    for (int i = 0; i < 2; ++i) { const int byte = ((wid + 8 * i) * 64 + lane) * 16, sub = byte >> 9, el = (byte & 511) >> 1, kk = (sub >> 2) * 8 + (el >> 5), c = (sub & 3) * 32 + (el & 31);
        const int k = (kk & ~0xC) | ((kk & 4) << 1) | ((kk & 8) >> 1); voff[i] = (unsigned)(k * 256 + c * 2); }
    const unsigned vb0 = (unsigned)(size_t)V_lds + (unsigned)v_rd_base(lane);
    bf16x8 qr[12];
#pragma unroll
    for (int d0 = 0; d0 < 12; ++d0) qr[d0] = *(const bf16x8*)(Qh + (size_t)qrow * DKP + d0 * 16 + hi * 8);
#define AT_JJ(t) (rev ? j_lo + NT - 1 - (t) : j_lo + (t))
#define AT_SLOAD(t, bf) do { const char* kt = (const char*)(Kh + (size_t)AT_JJ(t) * KVBLK * DKP); const char* vt = (const char*)(Vh + (size_t)AT_JJ(t) * KVBLK * DV); \
        _Pragma("unroll") for (int i_ = 0; i_ < 3; ++i_) __builtin_amdgcn_global_load_lds((const unsigned*)(kt + koff[i_]), (LAS unsigned*)(K_lds + (bf) * SHM_K + (wid + 8 * i_) * 1024), 16, 0, 0); \
        if (wid == 0) __builtin_amdgcn_global_load_lds((const unsigned*)(kt + koff3), (LAS unsigned*)(K_lds + (bf) * SHM_K + 24 * 1024), 16, 0, 0); \
        _Pragma("unroll") for (int i_ = 0; i_ < 2; ++i_) __builtin_amdgcn_global_load_lds((const unsigned*)(vt + voff[i_]), (LAS unsigned*)(V_lds + (bf) * SHM_V + (wid + 8 * i_) * 1024), 16, 0, 0); } while (0)
    AT_SLOAD(0, 0); VM_WAIT();
    __syncthreads();
    float m_reg = -1e30f, l_reg = 0.f; f32x16 o[4] = {};
    f32x16 p0, p1; float mn, alpha; bf16x8 pa0, pa1, pa2, pa3;
#define AT_TILE(t, BUF) do { \
        if ((t) + 1 < NT) AT_SLOAD((t) + 1, (BUF) ^ 1); \
        AT_SBAR(); qkt(p0, p1, K_lds + (BUF) * SHM_K, r32, hi, qr); AT_SBAR(); \
        bool bgi_ = false; \
        if (BG_IN_ATTN) { if (bgp >= 0) { if ((t) + 1 < NT) asm volatile("s_waitcnt vmcnt(5)" ::: "memory"); else VM_WAIT(); bg_flush(bgws, bgp, bscr, lane); bgp = -1; LDS_WAIT(); } \
            if ((unsigned)(bgt + wid) % 5u < 3u) { const int bj_ = bgk * bgn + bgw; if (bj_ < BG_ITEMS) { bg_issue(bga, bj_, bscr, lane); bgp = bj_; ++bgk; bgi_ = true; } } ++bgt; } AT_SBAR(); \
        { const int jj_ = AT_JJ(t), kb_ = jj_ * KVBLK; if (jj_ == j_lo) mask_pad(p0, p1); if (kb_ + KVBLK - 1 > qlo) mask_causal(p0, p1, qrow - kb_ - 4 * hi); } \
        partialSM(p0, p1, m_reg, mn, alpha); \
        if (__any(alpha < 1.f)) { if (hi == 0) al_l[r32] = alpha; LDS_WAIT(); \
            _Pragma("unroll") for (int d_ = 0; d_ < 4; ++d_) _Pragma("unroll") for (int r = 0; r < 16; ++r) o[d_][r] *= al_l[crow(r, hi)]; } \
        finishSM(p0, p1, mn, alpha, l_reg, pa0, pa1, pa2, pa3); AT_SBAR(); \
        pv_tile<BUF>(o, vb0, pa0, pa1, pa2, pa3); \
        if (bgi_) asm volatile("s_waitcnt vmcnt(8)" ::: "memory"); else VM_WAIT(); LDS_WAIT(); __builtin_amdgcn_s_barrier(); } while (0)
    for (int t = 0; t < NT; t += 2) { AT_TILE(t, 0); if (t + 1 < NT) AT_TILE(t + 1, 1); }
    if (hi == 0) li_l[r32] = l_reg; LDS_WAIT();
    float rli[16];
#pragma unroll
    for (int r = 0; r < 16; ++r) { const float lv = li_l[crow(r, hi)]; rli[r] = lv > 0.f ? __builtin_amdgcn_rcpf(lv) : 0.f; }
    bf16_t* Ow = Oh + (size_t)qlo * DM;
#pragma unroll
    for (int r = 0; r < 16; ++r) { const int orow = crow(r, hi);
#pragma unroll
        for (int d0 = 0; d0 < 4; ++d0) { const float v = o[d0][r] * rli[r]; const float vn = __shfl_xor(v, 1);
            if ((r32 & 1) == 0) *(unsigned*)(Ow + (size_t)orow * DM + d0 * 32 + r32) = cvt_pk_bf16(v, vn); } }
    __syncthreads();
#undef AT_SLOAD
#undef AT_JJ
#undef AT_TILE
}
}
__device__ __forceinline__ void p3_attn(Frame& F, const Args& a) {
    unsigned char* ws = F.ws; const bf16_t* QP = (const bf16_t*)(ws + WS_L_QP); const bf16_t* KP = (const bf16_t*)(ws + WS_L_KP); const bf16_t* VP = (const bf16_t*)(ws + WS_L_VP);
    bf16_t* O = (bf16_t*)(ws + WS_L_O);
    att::lptr lds = (att::lptr)F.lds;
    int bgt = 0, bgk = 0, bgp = -1; const int bgw = F.vcu * 8 + F.wave, bgn = F.G * 8;
    for (int L = F.vcu; L < NH * 16; L += F.G) {
        const int nseq = L < NH ? 3 : 2;
        for (int sq = 0; sq < nseq; ++sq) {
            const int head = sq < 2 ? (L >> 4) : L, x = L & 15, b = sq == 0 ? 32 - x : (sq == 1 ? x + 1 : 0);
            att::attn_block(QP + (size_t)head * R * DKP, KP + (size_t)head * R * DKP, VP + (size_t)head * R * DV, O + head * DV, b, sq == 1, lds, a, ws, bgt, bgk, bgp, bgw, bgn);
        }
    }
    if (BG_IN_ATTN) {
        LAS unsigned char* bscr = (LAS unsigned char*)(F.lds + att::LDS_NEED) + F.wave * 8192;
        VM_WAIT(); asm volatile("" ::: "memory");
        if (bgp >= 0) { bg_flush(ws, bgp, bscr, F.lane); LDS_WAIT(); asm volatile("" ::: "memory"); }
        for (int j = bgk * bgn + bgw; j < BG_ITEMS; j += bgn) { bg_issue(a, j, bscr, F.lane); VM_WAIT(); asm volatile("" ::: "memory"); bg_flush(ws, j, bscr, F.lane); LDS_WAIT(); asm volatile("" ::: "memory"); }
    }
}

__device__ __forceinline__ void ln_core(f32x4 (&v)[8], const float* g, const float* b, int lane, float* mean_out = nullptr, float* rstd_out = nullptr) {
    float s = 0.f;
#pragma unroll
    for (int j = 0; j < 8; ++j) s += (v[j][0] + v[j][1]) + (v[j][2] + v[j][3]);
    const float mean = wave_sum(s) * (1.f / DM); float s2 = 0.f;
#pragma unroll
    for (int j = 0; j < 8; ++j) { v[j] = v[j] - mean; s2 += (v[j][0] * v[j][0] + v[j][1] * v[j][1]) + (v[j][2] * v[j][2] + v[j][3] * v[j][3]); }
    const float rstd = 1.f / sqrtf(wave_sum(s2) * (1.f / DM) + LN_EPS);
    if (mean_out) { *mean_out = mean; *rstd_out = rstd; }
#pragma unroll
    for (int j = 0; j < 8; ++j) { const f32x4 gg = *(const f32x4*)(g + 4 * lane + 256 * j), bb = *(const f32x4*)(b + 4 * lane + 256 * j); v[j] = v[j] * rstd * gg + bb; }
}
__device__ __forceinline__ void ln_phase(Frame& F, const float* Y, const float* g, const float* b, float* stats, bf16_t* HB, bool emu = false) {
    const int gw = F.vcu * 8 + F.wave, NGW = F.G * 8;
    f32x4 v[8], vn[8]; int row = PADR + gw;
    if (row < R) {
#pragma unroll
        for (int j = 0; j < 8; ++j) v[j] = *(const f32x4*)(Y + (size_t)row * DM + 4 * F.lane + 256 * j); }
    for (; row < R; row += NGW) {
        const int rn = row + NGW;
        if (rn < R) {
#pragma unroll
            for (int j = 0; j < 8; ++j) vn[j] = *(const f32x4*)(Y + (size_t)rn * DM + 4 * F.lane + 256 * j); }
        float mean, rstd; ln_core(v, g, b, F.lane, &mean, &rstd);
        if (F.lane == 0) *(f32x2*)(stats + (size_t)row * 2) = (f32x2){mean, rstd};
#pragma unroll
        for (int j = 0; j < 8; ++j) *(u32x2*)(HB + (size_t)row * DM + 4 * F.lane + 256 * j) = pack4((FP8_EMU && emu) ? q8v(v[j], 16.f) : v[j]);
#pragma unroll
        for (int j = 0; j < 8; ++j) v[j] = vn[j];
    }
}

template <int MODE>
__device__ __forceinline__ void skinny_meta(Frame& F, const bf16_t* A, int lda, const bf16_t* Bt, int K, float* out, const float* res, const float* g = nullptr, const float* b = nullptr) {
    LAS float* red = (LAS float*)F.lds;
    const int lane = F.lane, i16 = lane & 15, kq = lane >> 4, kc = K / 8;
    for (int ng = F.vcu; ng < DM / 16; ng += F.G) {
        const bf16_t* ap = A + (size_t)(PADR + i16) * lda + F.wave * kc + 8 * kq; const bf16_t* bp = Bt + (size_t)(ng * 16 + i16) * K + F.wave * kc + 8 * kq;
        f32x4 acc = (f32x4){0.f, 0.f, 0.f, 0.f};
#pragma unroll 8
        for (int k0 = 0; k0 < kc; k0 += 32) acc = __builtin_amdgcn_mfma_f32_16x16x32_bf16(*(const bf16x8*)(ap + k0), *(const bf16x8*)(bp + k0), acc, 0, 0, 0);
        *(LAS f32x4*)(red + (F.wave * 64 + lane) * 4) = acc;
        __syncthreads();
        if (F.tid < 256) { const int e = F.tid & 63, r = F.tid >> 6; float sum = 0.f;
#pragma unroll
            for (int w = 0; w < 8; ++w) sum += red[(w * 64 + e) * 4 + r];
            const int row = PADR + 4 * (e >> 4) + r, col = ng * 16 + (e & 15);
            if (MODE == 0) sum += ALPHA * res[(size_t)(row - PADR) * DM + col]; else if (MODE == 1) { const float mean = res[(size_t)row * 2], rstd = res[(size_t)row * 2 + 1]; sum += ALPHA * ((out[(size_t)row * DM + col] - mean) * rstd * g[col] + b[col]); }
            if (MODE == 2) ((bf16_t*)out)[(size_t)row * DM + col] = f2bf(sum); else out[(size_t)row * DM + col] = sum; }
        __syncthreads();
    }
}


__device__ __forceinline__ void calc_c12(Frame& F, const bf16_t* WT, int N, const float* g, const float* b, float* c1, float* c2, int gw, int NGW) {
    const int lane = F.lane;
    for (int n = gw; n < N; n += NGW) { float s1 = 0.f, s2 = 0.f;
#pragma unroll
        for (int j = 0; j < 4; ++j) { const int k = 8 * lane + 512 * j; const u32x4 w = *(const u32x4*)(WT + (size_t)n * DM + k);
            const f32x4 g0 = *(const f32x4*)(g + k), g1 = *(const f32x4*)(g + k + 4), b0 = *(const f32x4*)(b + k), b1 = *(const f32x4*)(b + k + 4);
            const f32x4 w0 = (f32x4){bf_lo(w.x), bf_hi(w.x), bf_lo(w.y), bf_hi(w.y)}, w1 = (f32x4){bf_lo(w.z), bf_hi(w.z), bf_lo(w.w), bf_hi(w.w)};
            const f32x4 q0 = w0 * b0 / g0, q1 = w1 * b1 / g1;
            s1 += ((w0[0] + w0[1]) + (w0[2] + w0[3])) + ((w1[0] + w1[1]) + (w1[2] + w1[3])); s2 += ((q0[0] + q0[1]) + (q0[2] + q0[3])) + ((q1[0] + q1[1]) + (q1[2] + q1[3])); }
        s1 = wave_sum(s1); s2 = wave_sum(s2);
        if (lane == 0) { c1[n] = s1; c2[n] = s2; } }
}
__device__ __forceinline__ void meta_stats(Frame& F, const float* Y, volatile LAS float* ms) {
    for (int i = F.wave; i < 16; i += 8) { f32x4 v[8]; float s = 0.f;
#pragma unroll
        for (int j = 0; j < 8; ++j) { v[j] = *(const f32x4*)(Y + (size_t)(PADR + i) * DM + 4 * F.lane + 256 * j); s += (v[j][0] + v[j][1]) + (v[j][2] + v[j][3]); }
        const float mean = wave_sum(s) * (1.f / DM); float s2 = 0.f;
#pragma unroll
        for (int j = 0; j < 8; ++j) { const f32x4 d = v[j] - mean; s2 += (d[0] * d[0] + d[1] * d[1]) + (d[2] * d[2] + d[3] * d[3]); }
        const float rstd = 1.f / sqrtf(wave_sum(s2) * (1.f / DM) + LN_EPS);
        if (F.lane == 0) { ms[2 * i] = mean; ms[2 * i + 1] = rstd; } }
    __syncthreads();
}
__device__ __forceinline__ void skinny_meta_ln(Frame& F, const float* Y, const volatile LAS float* ms, const bf16_t* Bt, const float* c2, bf16_t* out) {
    LAS float* red = (LAS float*)F.lds;
    const int lane = F.lane, i16 = lane & 15, kq = lane >> 4, kc = DM / 8; const float mean = ms[2 * i16], rstd = ms[2 * i16 + 1];
    for (int ng = F.vcu; ng < DM / 16; ng += F.G) {
        const float* ap = Y + (size_t)(PADR + i16) * DM + F.wave * kc + 8 * kq; const bf16_t* bp = Bt + (size_t)(ng * 16 + i16) * DM + F.wave * kc + 8 * kq;
        f32x4 acc = (f32x4){0.f, 0.f, 0.f, 0.f};
#pragma unroll 8
        for (int k0 = 0; k0 < kc; k0 += 32) { const f32x4 a0 = (*(const f32x4*)(ap + k0) - mean) * rstd, a1 = (*(const f32x4*)(ap + k0 + 4) - mean) * rstd;
            acc = __builtin_amdgcn_mfma_f32_16x16x32_bf16(__builtin_bit_cast(bf16x8, pack8(a0, a1)), *(const bf16x8*)(bp + k0), acc, 0, 0, 0); }
        *(LAS f32x4*)(red + (F.wave * 64 + lane) * 4) = acc;
        __syncthreads();
        if (F.tid < 256) { const int e = F.tid & 63, r = F.tid >> 6; float sum = 0.f;
#pragma unroll
            for (int w = 0; w < 8; ++w) sum += red[(w * 64 + e) * 4 + r];
            const int row = PADR + 4 * (e >> 4) + r, col = ng * 16 + (e & 15);
            out[(size_t)row * DM + col] = f2bf(sum + c2[col]); }
        __syncthreads();
    }
}

__device__ __forceinline__ f32x4 ld4bf(const bf16_t* p) { const u32x2 w = *(const u32x2*)p; return (f32x4){bf_lo(w.x), bf_hi(w.x), bf_lo(w.y), bf_hi(w.y)}; }
template <int W> __device__ __forceinline__ void pool_run(const bf16_t* HP, bf16_t* PB, int row0, int t) {
    f32x4 x[32], h[W - 1];
#pragma unroll
    for (int i = 0; i < W - 1; ++i) h[i] = ld4bf(HP + (size_t)(row0 - (W - 1) + i) * DM + 4 * t);
#pragma unroll
    for (int rr = 0; rr < 32; ++rr) x[rr] = ld4bf(HP + (size_t)(row0 + rr) * DM + 4 * t);
    f32x4 s = (f32x4){0.f, 0.f, 0.f, 0.f};
#pragma unroll
    for (int i = 0; i < W - 1; ++i) s += h[i];
    constexpr float iw = 1.0f / (float)W;
#pragma unroll
    for (int rr = 0; rr < 32; ++rr) { s += x[rr]; *(u32x2*)(PB + (size_t)(row0 + rr) * DM + 4 * t) = pack4(s * iw - x[rr]);
        const int old = rr - (W - 1); s -= old >= 0 ? x[old >= 0 ? old : 0] : h[old >= 0 ? 0 : old + (W - 1)]; }
}
__device__ __forceinline__ void p10_pool(Frame& F) {
    const bf16_t* HP = (const bf16_t*)(F.ws + WS_L_HP); bf16_t* PB = (bf16_t*)(F.ws + WS_L_PB);
    const int t = F.tid, g = F.wave >> 1;
    for (int run = blockIdx.x; run < SEQ / 32; run += F.G) { const int row0 = ROW0 + 32 * run;
        if (g == 0) pool_run<2>(HP, PB, row0, t); else if (g == 1) pool_run<4>(HP, PB, row0, t); else if (g == 2) pool_run<8>(HP, PB, row0, t); else pool_run<16>(HP, PB, row0, t); }
}

__device__ __forceinline__ void p13_ln_route(Frame& F, const Args& a) {
    unsigned char* ws = F.ws; const float* Y = (const float*)(ws + WS_Y); unsigned char* XG = ws + WS_M_XG;
    int* rinfo = (int*)(ws + WS_RINFO); float* tokg = (float*)(ws + WS_TOKG); int* tokep = (int*)(ws + WS_TOKG + 65536);
    LAS float* wr_l = (LAS float*)F.lds;
    for (int i = F.tid; i < DM * 8 / 4; i += 512) { const int c = i >> 1; *(LAS f32x4*)(wr_l + c * 8 + (c >> 2) * 4 + (i & 1) * 4) = ((const f32x4*)a.in[I_MROUTER])[i]; }
    __syncthreads();
    const float* g = a.in[I_LNMG] + DM; const float* b = a.in[I_LNMB] + DM;
    const int gw = F.vcu * 8 + F.wave, NGW = F.G * 8, lane = F.lane;
    for (int tok = gw; tok < SEQ; tok += NGW) { const int row = ROW0 + tok; f32x4 v[8];
#pragma unroll
        for (int j = 0; j < 8; ++j) v[j] = *(const f32x4*)(Y + (size_t)row * DM + 4 * lane + 256 * j);
        ln_core(v, g, b, lane);
        float lg[8];
#pragma unroll
        for (int e = 0; e < 8; ++e) lg[e] = 0.f;
        const LAS float* wl = wr_l + lane * 36;
#pragma unroll
        for (int j = 0; j < 8; ++j) {
#pragma unroll
            for (int i = 0; i < 4; ++i) { const f32x4 w0 = *(const LAS f32x4*)(wl + j * 2304 + i * 8), w1 = *(const LAS f32x4*)(wl + j * 2304 + i * 8 + 4); const float x = v[j][i];
                lg[0] += x * w0[0]; lg[1] += x * w0[1]; lg[2] += x * w0[2]; lg[3] += x * w0[3]; lg[4] += x * w1[0]; lg[5] += x * w1[1]; lg[6] += x * w1[2]; lg[7] += x * w1[3]; }
            __builtin_amdgcn_sched_barrier(0); }
#pragma unroll
        for (int e = 0; e < 8; ++e) lg[e] = wave_sum(lg[e]) + a.in[I_MBROUTER][e];
        int e0 = 0; float v0 = lg[0];
#pragma unroll
        for (int e = 1; e < 8; ++e) if (lg[e] > v0) { v0 = lg[e]; e0 = e; }
        int e1 = -1; float v1 = -__builtin_inff();
#pragma unroll
        for (int e = 0; e < 8; ++e) if (e != e0 && lg[e] > v1) { v1 = lg[e]; e1 = e; }
        const float g1 = 1.0f / (1.0f + expf(v0 - v1)), g0 = 1.0f - g1;
        int p0 = 0, p1 = 0;
        if (lane == 0) { p0 = (int)atomicAdd(F.ctl + CW_CNT + 64 * e0, 1u); p1 = (int)atomicAdd(F.ctl + CW_CNT + 64 * e1, 1u);
            rinfo[e0 * CAP + p0] = tok * 2; rinfo[e1 * CAP + p1] = tok * 2 + 1; tokg[tok * 2] = g0; tokg[tok * 2 + 1] = g1; tokep[tok * 2] = e0 * CAP + p0; tokep[tok * 2 + 1] = e1 * CAP + p1; }
        p0 = __shfl(p0, 0); p1 = __shfl(p1, 0);
        unsigned char* x0 = XG + ((size_t)e0 * CAP + p0) * DM; unsigned char* x1 = XG + ((size_t)e1 * CAP + p1) * DM;
#pragma unroll
        for (int j = 0; j < 8; ++j) { const unsigned pk = pack4_fp8_sc(v[j][0], v[j][1], v[j][2], v[j][3], 1.0f / SX8);
            *(unsigned*)(x0 + 4 * lane + 256 * j) = pk; *(unsigned*)(x1 + 4 * lane + 256 * j) = pk; } }
}
__device__ __forceinline__ void moe_tables(Frame& F, int nNx) {
    __syncthreads();
    if (F.tid == 0) { int pu = 0, seg = 0; int cnt[8];
#pragma unroll
        for (int e = 0; e < 8; ++e) cnt[e] = (int)__hip_atomic_load(F.ctl + CW_CNT + 64 * e, __ATOMIC_RELAXED, __HIP_MEMORY_SCOPE_AGENT);
#pragma unroll
        for (int e = 0; e < 8; ++e) { const int c = cnt[e]; const int nt = (c + 255) >> 8;
            F.MISC[e] = c; F.MISC[8 + e] = nt; F.MISC[16 + e] = pu; F.MISC[32 + e] = seg; pu += nt * nNx; seg += nt * 256; }
        F.MISC[24] = pu; }
    __syncthreads();
}
__device__ __forceinline__ void moe_tables_down(Frame& F) {
    __syncthreads();
    if (F.tid == 0) { int tp = 0, puA = 0, puB = 0, ovf = 0; int cnt[8];
#pragma unroll
        for (int e = 0; e < 8; ++e) cnt[e] = (int)__hip_atomic_load(F.ctl + CW_CNT + 64 * e, __ATOMIC_RELAXED, __HIP_MEMORY_SCOPE_AGENT);
#pragma unroll
        for (int e = 0; e < 8; ++e) { const int c = cnt[e]; const int nt = (c + 255) >> 8;
            int nA = FULL_TILES - tp; nA = nA < 0 ? 0 : (nA > nt ? nt : nA); const int nB = nt - nA;
            F.MISC[e] = c; F.MISC[8 + e] = nA; F.MISC[16 + e] = puA; F.MISC[32 + e] = tp * 256; F.MISC[40 + e] = 0; F.MISC[48 + e] = 0;
            F.MISC[128 + e] = c; F.MISC[136 + e] = nB; F.MISC[144 + e] = puB; F.MISC[160 + e] = tp * 256; F.MISC[168 + e] = nA; F.MISC[176 + e] = ovf;
            puA += nA * 8; puB += nB * 8 * KSB; ovf += nB; tp += nt; }
        F.MISC[24] = puA; F.MISC[152] = puB; }
    __syncthreads();
}
__device__ __forceinline__ void p16_final(Frame& F, const Args& a) {
    unsigned char* ws = F.ws; const float* Y = (const float*)(ws + WS_Y); const bf16_t* YM = (const bf16_t*)(ws + WS_M_XG); const bf16_t* YX = (const bf16_t*)(ws + WS_M_XG + 64 * MiB);
    const float* tokg = (const float*)(ws + WS_TOKG); const int* tokep = (const int*)(ws + WS_TOKG + 65536);
    const float* g = a.in[I_LNFG] + DM; const float* b = a.in[I_LNFB] + DM; const float* g3 = a.in[I_LNMG] + DM; const float* b3 = a.in[I_LNMB] + DM;
    const int gw = F.vcu * 8 + F.wave, NGW = F.G * 8;
    __syncthreads();
    if (F.tid == 0) { int tp = 0; int cnt[8];
#pragma unroll
        for (int e = 0; e < 8; ++e) cnt[e] = (int)__hip_atomic_load(F.ctl + CW_CNT + 64 * e, __ATOMIC_RELAXED, __HIP_MEMORY_SCOPE_AGENT);
#pragma unroll
        for (int e = 0; e < 8; ++e) { F.MISC[200 + e] = tp; tp += (cnt[e] + 255) >> 8; } }
    __syncthreads();
    const int lane0 = F.lane;
    for (int tok = gw; tok < SEQ; tok += NGW) { const int row = ROW0 + tok; f32x4 v[8]; const float g0 = tokg[tok * 2], g1 = tokg[tok * 2 + 1];
        int lane = lane0; asm volatile("" : "+v"(lane));
        int sr0 = -1, sr1 = -1;
        { const int ep = __builtin_amdgcn_readfirstlane(tokep[tok * 2]), e = ep >> 13, p = ep & (CAP - 1), gid = F.MISC[200 + e] + (p >> 8); if (gid >= FULL_TILES) sr0 = (gid - FULL_TILES) * 256 + (p & 255); }
        { const int ep = __builtin_amdgcn_readfirstlane(tokep[tok * 2 + 1]), e = ep >> 13, p = ep & (CAP - 1), gid = F.MISC[200 + e] + (p >> 8); if (gid >= FULL_TILES) sr1 = (gid - FULL_TILES) * 256 + (p & 255); }
        sr0 = __builtin_amdgcn_readfirstlane(sr0); sr1 = __builtin_amdgcn_readfirstlane(sr1);
#pragma unroll
        for (int j = 0; j < 8; ++j) v[j] = *(const f32x4*)(Y + (size_t)row * DM + 4 * lane + 256 * j);
        ln_core(v, g3, b3, lane);
#pragma unroll
        for (int j = 0; j < 8; ++j) { const int col = 4 * lane + 256 * j;
            f32x4 y0 = ld4bf(YM + ((size_t)0 * SEQ + tok) * DM + col), y1 = ld4bf(YM + ((size_t)1 * SEQ + tok) * DM + col);
            if (sr0 >= 0) {
#pragma unroll
                for (int q = 0; q < KSB - 1; ++q) y0 += ld4bf(YX + ((size_t)q * OVF_ROWS + sr0) * DM + col); }
            if (sr1 >= 0) {
#pragma unroll
                for (int q = 0; q < KSB - 1; ++q) y1 += ld4bf(YX + ((size_t)q * OVF_ROWS + sr1) * DM + col); }
            v[j] = v[j] * ALPHA + y0 * g0 + y1 * g1; if (j & 1) __builtin_amdgcn_sched_barrier(0); }
        ln_core(v, g, b, lane);
#pragma unroll
        for (int j = 0; j < 8; ++j) *(f32x4*)(a.out + (size_t)tok * DM + 4 * lane + 256 * j) = v[j]; }
}

__global__ void __launch_bounds__(512, 2) fwd(Args args) {
    extern __shared__ __attribute__((aligned(16))) unsigned char lds[];
    Frame F;
    F.lds = (LAS unsigned char*)lds; F.MISC = (volatile LAS int*)(F.lds + MISC_OFF);
    F.tid = threadIdx.x; F.lane = F.tid & 63; F.wave = __builtin_amdgcn_readfirstlane(F.tid >> 6);
    F.G = gridDim.x; { const int bx = blockIdx.x; F.vcu = (F.G % 8 == 0) ? (bx % 8) * (F.G / 8) + bx / 8 : bx; }
    F.ws = args.ws; F.ctl = (unsigned*)(args.ws + WS_CTL);
    unsigned char* ws = args.ws;
    for (int u = F.tid; u < 256; u += 512) F.MISC[u] = 0;
    __syncthreads();
#if MK_ONE_LAUNCH
    XcdBarrier bar = xcd_barrier_post(F.ctl + CW_BAR, (volatile LAS unsigned*)(F.MISC + 64));
#define GRID_BAR() xcd_barrier(bar)
#else
#define GRID_BAR() do { } while (0)
#endif
    const int lo = args.ph_lo, hi = args.ph_hi;
#define IN(k) (lo <= (k) && (k) < hi)
#define SEAM(k) do { if (IN(k) && IN((k) + 1)) GRID_BAR(); } while (0)
#define REP(k) _Pragma("unroll") for (int rep_ = 0; rep_ < ((((DUP_MASK) >> (k)) & 1u) ? 2 : 1); ++rep_)
    LAS unsigned char* ring = F.lds;
    const int bx = (int)blockIdx.x;

    if (IN(0)) REP(0) { p0_prologue(F, args); SEAM(0); }
    if (IN(1)) REP(1) {
        pg8::DenseSched<0> S{NPAN, NIN / 256, F.G, bx, 0, (const char*)(ws + WS_L_H0B), (const char*)(ws + WS_W_IN), (size_t)256 * DM * 2, (size_t)256 * DM * 2};
        pg8::EpiIn E{ws, args.in[I_FBIAS]};
        if (F.G != 256) calc_c12(F, (const bf16_t*)(ws + WS_W_PIN), DM, args.in[I_LNFG], args.in[I_LNFB], (float*)(ws + WS_C12), (float*)(ws + WS_C12) + DM, F.vcu * 8 + F.wave, F.G * 8);
        pg8::gemm_phase(ring, DM, DM, DM, S, E);
        if (F.G == 256 && bx >= 49) { calc_c12(F, (const bf16_t*)(ws + WS_W_PIN), DM, args.in[I_LNFG], args.in[I_LNFB], (float*)(ws + WS_C12), (float*)(ws + WS_C12) + DM, (bx - 49) * 8 + F.wave, 207 * 8);
            convert_range(F, args, I_A, I_B, (bx - 49) * 8 + F.wave, 207 * 8); }
        SEAM(1);
    }
    if (IN(2)) REP(2) {
        p2_ext(F);
        pg8::DenseSched<1> S{NPAN, NUP / 256, F.G, bx, 0, (const char*)(ws + WS_L_CQKV), (const char*)(ws + WS_W_UP), (size_t)256 * 1024 * 2, (size_t)256 * 512 * 2};
        pg8::EpiUp E{(const float*)(ws + WS_SSQ), (const float*)(ws + WS_CS), (bf16_t*)(ws + WS_L_QP), (bf16_t*)(ws + WS_L_KP), (bf16_t*)(ws + WS_L_VP)};
        pg8::gemm_phase(ring, 512, 1024, 512, S, E); SEAM(2);
    }
#if NAIVE_ATTN
    if (IN(3)) REP(3) { p3_attn_naive(F); SEAM(3); }
#else
    if (IN(3)) REP(3) { p3_attn(F, args); SEAM(3); }
#endif
    if (IN(4)) REP(4) {
        pg8::DenseSched<0> S{32, 8, F.G, bx, 1, (const char*)(ws + WS_L_O), (const char*)(ws + WS_W_OUT), (size_t)256 * DM * 2, (size_t)256 * DM * 2};
        pg8::EpiRes<0> E{(float*)(ws + WS_Y), nullptr, args.in[I_X], args.in[I_META], nullptr, nullptr};
        pg8::gemm_phase(ring, DM, DM, DM, S, E);
        skinny_meta<0>(F, (const bf16_t*)(ws + WS_L_O), DM, (const bf16_t*)(ws + WS_W_OUT), DM, (float*)(ws + WS_Y), args.in[I_META]); SEAM(4);
    }
    if (IN(5)) REP(5) { ln_phase(F, (const float*)(ws + WS_Y), args.in[I_LNMG], args.in[I_LNMB], (float*)(ws + WS_L_H1F), (bf16_t*)(ws + WS_L_H1B), true); SEAM(5); }
    if (IN(6)) REP(6) {
        pg8::DenseSched<0> S{NPAN, 2 * FFN / 256, F.G, bx, 0, (const char*)(ws + WS_L_H1B), (const char*)(ws + WS_W_GU), (size_t)256 * DM * 2, (size_t)256 * DM * 2};
        pg8::EpiGU E{(bf16_t*)(ws + WS_L_ACT), FFN};
        pg8::gemm_phase(ring, DM, DM, DM, S, E);
        if (F.G == 256 && bx >= 172) convert_range(F, args, I_B, I10, (bx - 172) * 8 + F.wave, 84 * 8);
        SEAM(6);
    }
    if (IN(7)) REP(7) {
        pg8::DenseSched<0> S{32, 8, F.G, bx, 1, (const char*)(ws + WS_L_ACT), (const char*)(ws + WS_W_DN), (size_t)256 * FFN * 2, (size_t)256 * FFN * 2};
        pg8::EpiResStat E{(float*)(ws + WS_Y), (const float*)(ws + WS_L_H1F), args.in[I_LNMG], args.in[I_LNMB], (bf16_t*)(ws + WS_L_H2B), (float*)(ws + WS_SLOT), F.lds};
        pg8::gemm_phase(ring, FFN, FFN, FFN, S, E);
        skinny_meta<1>(F, (const bf16_t*)(ws + WS_L_ACT), FFN, (const bf16_t*)(ws + WS_W_DN), FFN, (float*)(ws + WS_Y), (const float*)(ws + WS_L_H1F), args.in[I_LNMG], args.in[I_LNMB]); SEAM(7);
    }
    if (IN(9)) REP(9) {
        pg8::DenseSched<0> S{32, 8, F.G, bx, 1, (const char*)(ws + WS_L_H2B), (const char*)(ws + WS_W_PIN), (size_t)256 * DM * 2, (size_t)256 * DM * 2};
        pg8::EpiPoolIn E{(bf16_t*)(ws + WS_L_HP), (const float*)(ws + WS_SLOT), (const float*)(ws + WS_C12), (const float*)(ws + WS_C12) + DM, (float*)(ws + WS_L_H2F)};
        volatile LAS float* ms = (volatile LAS float*)(F.MISC + 208);
        meta_stats(F, (const float*)(ws + WS_Y), ms);
        pg8::gemm_phase(ring, DM, DM, DM, S, E);
        skinny_meta_ln(F, (const float*)(ws + WS_Y), ms, (const bf16_t*)(ws + WS_W_PIN), (const float*)(ws + WS_C12) + DM, (bf16_t*)(ws + WS_L_HP)); SEAM(9);
    }
    if (IN(10)) REP(10) { p10_pool(F); SEAM(10); }
    if (IN(11)) REP(11) {
        pg8::DenseSched<2> S{32, 8, F.G, bx, 1, (const char*)(ws + WS_L_PB), (const char*)(ws + WS_W_GRP), (size_t)256 * DM * 2, (size_t)256 * 512 * 2};
        pg8::EpiBf E{(bf16_t*)(ws + WS_L_YP)};
        pg8::gemm_phase(ring, 512, DM, 512, S, E); SEAM(11);
    }
    if (IN(12)) REP(12) {
        pg8::DenseSched<0> S{32, 8, F.G, bx, 1, (const char*)(ws + WS_L_YP), (const char*)(ws + WS_W_POUT), (size_t)256 * DM * 2, (size_t)256 * DM * 2};
        pg8::EpiRes<1> E{(float*)(ws + WS_Y), (const float*)(ws + WS_L_H2F), nullptr, nullptr, args.in[I_LNFG], args.in[I_LNFB]};
        pg8::gemm_phase(ring, DM, DM, DM, S, E); SEAM(12);
    }
    if (IN(13)) REP(13) { p13_ln_route(F, args); SEAM(13); }
    if (IN(14)) REP(14) {
        moe_tables(F, 2 * FE / 256);
        pg8::MoeSched<0> S{F.MISC, F.G, bx, 2 * FE / 256, (const char*)(ws + WS_M_XG), (const char*)(ws + WS_W_MGU), (size_t)DM, (size_t)2 * FE * DM, (size_t)256 * DM, 0};
        pg8::EpiGU8 E{ws + WS_M_ACT, F.MISC};
        pg8::gemm_phase<true>(ring, DM / 2, DM / 2, DM / 2, S, E); SEAM(14);
    }
    if (IN(15)) REP(15) {
        moe_tables_down(F);
        pg8::EpiMoeDown E{(bf16_t*)(ws + WS_M_XG), (bf16_t*)(ws + WS_M_XG + 64 * MiB), (const int*)(ws + WS_RINFO)};
        { pg8::MoeSched<1> S{F.MISC, F.G, bx, 8, (const char*)(ws + WS_M_ACT), (const char*)(ws + WS_W_MDN), (size_t)FE, (size_t)DM * FE, (size_t)256 * FE, 0};
          pg8::gemm_phase<true>(ring, FE / 2, FE / 2, FE / 2, S, E); }
        { pg8::MoeSched<1> S{F.MISC + 128, F.G, bx, 8 * KSB, (const char*)(ws + WS_M_ACT), (const char*)(ws + WS_W_MDN), (size_t)FE, (size_t)DM * FE, (size_t)256 * FE, (size_t)(FE / KSB)};
          pg8::gemm_phase<true>(ring, FE / KSB / 2, FE / 2, FE / 2, S, E); }
        SEAM(15);
    }
    if (IN(16)) REP(16) { p16_final(F, args); }
#undef IN
#undef SEAM
}

extern "C" void kernel_launch(void* const* d_in, const int* in_sizes, int n_in, void* d_out, int out_size, void* d_ws, size_t ws_size, hipStream_t stream) {
    static int grid = 0;
    if (grid == 0) {
        if (n_in != 25 || out_size != SEQ * DM || ws_size < WS_END) { fprintf(stderr, "kernel_launch: unexpected shapes (n_in %d, out %d, ws %zu < %zu)\n", n_in, out_size, ws_size, (size_t)WS_END); grid = -1; return; }
        int dev = 0, cus = 0, per_cu = 0;
        if (hipGetDevice(&dev) != hipSuccess || hipDeviceGetAttribute(&cus, hipDeviceAttributeMultiprocessorCount, dev) != hipSuccess) { grid = -1; return; }
        if (hipFuncSetAttribute((const void*)fwd, hipFuncAttributeMaxDynamicSharedMemorySize, LDS_BYTES) != hipSuccess) { fprintf(stderr, "kernel_launch: hipFuncSetAttribute failed\n"); grid = -1; return; }
        if (hipOccupancyMaxActiveBlocksPerMultiprocessor(&per_cu, (const void*)fwd, 512, LDS_BYTES) != hipSuccess || per_cu < 1) fprintf(stderr, "kernel_launch: occupancy query reports %d\n", per_cu);
        (void)hipGetLastError();
        grid = cus;
    }
    if (grid < 0) return;
    (void)hipMemsetAsync((char*)d_ws + WS_CTL, 0, CTL_ZERO_BYTES, stream);
    Args a{};
    for (int i = 0; i < 25; ++i) a.in[i] = (const float*)d_in[i];
    a.out = (float*)d_out; a.ws = (unsigned char*)d_ws;
#if MK_ONE_LAUNCH
    a.ph_lo = 0; a.ph_hi = NPHASE;
    hipLaunchKernelGGL(fwd, dim3(grid), dim3(512), LDS_BYTES, stream, a);
#else
    for (int p = 0; p < NPHASE; ++p) { a.ph_lo = p; a.ph_hi = p + 1; hipLaunchKernelGGL(fwd, dim3(grid), dim3(512), LDS_BYTES, stream, a); }
#endif
}
```

```cpp
#include <hip/hip_runtime.h>
#include <cstdio>
#include <cstdint>

#ifndef MK_ONE_LAUNCH
#define MK_ONE_LAUNCH 1
#endif
#ifndef DUP_MASK
#define DUP_MASK 0u
#endif
#ifndef NAIVE_ATTN
#define NAIVE_ATTN 0
#endif

#define GAS __attribute__((address_space(1)))
#define LAS __attribute__((address_space(3)))
typedef unsigned short bf16_t;
typedef short bf16x8 __attribute__((ext_vector_type(8)));
typedef float f32x4 __attribute__((ext_vector_type(4)));
typedef float f32x2 __attribute__((ext_vector_type(2)));
typedef unsigned u32x4 __attribute__((ext_vector_type(4)));
typedef unsigned u32x2 __attribute__((ext_vector_type(2)));

constexpr int DM = 2048, SEQ = 8192, NMETA = 16, LTOK = SEQ + NMETA;
constexpr int PADR = 240, ROW0 = 256, R = 8448, NPAN = 33;
constexpr int NH = 16, DKP = 192, DV = 128;
constexpr int NIN = 4352, NUP = 3584, FFN = 5632, NE = 8, FE = 7168, CAP = 8192, KS = 2;
constexpr float ALPHA = 1.41421356237309515f, LN_EPS = 1e-5f, RMS_EPS = 1e-6f;
constexpr float LOG2E = 1.4426950408889634f;
constexpr float QS_MLA = 0.07216878364870323f * LOG2E;
constexpr float SX8 = 16.f, SWGU8 = 512.f, SACT8 = 4.f, SWDN8 = 2048.f;
constexpr int FULL_TILES = 64, KSB = 7, OVF_ROWS = 2048;
constexpr float QS_FOX = 0.08838834764831845f * LOG2E;
__constant__ float INV_FREQ[32] = {1.000000000e+00f, 7.498942614e-01f, 5.623413324e-01f, 4.216965139e-01f, 3.162277639e-01f, 2.371373773e-01f, 1.778279394e-01f, 1.333521307e-01f,
    1.000000015e-01f, 7.498941571e-02f, 5.623413250e-02f, 4.216965288e-02f, 3.162277490e-02f, 2.371373773e-02f, 1.778279431e-02f, 1.333521493e-02f,
    9.999999776e-03f, 7.498941850e-03f, 5.623413250e-03f, 4.216964822e-03f, 3.162277630e-03f, 2.371373586e-03f, 1.778279431e-03f, 1.333521446e-03f,
    1.000000047e-03f, 7.498942432e-04f, 5.623413017e-04f, 4.216965172e-04f, 3.162277571e-04f, 2.371373703e-04f, 1.778279402e-04f, 1.333521504e-04f};

constexpr size_t MiB = 1u << 20;
constexpr size_t WS_CTL = 0, CTL_ZERO_BYTES = 65536;
constexpr size_t WS_CS = 1 * MiB;
constexpr size_t WS_SSQ = 3 * MiB + 256 * 1024;
constexpr size_t WS_SLOT = WS_SSQ;
constexpr size_t WS_C12 = 3 * MiB + 128 * 1024;
constexpr size_t WS_W_IN = 4 * MiB;
constexpr size_t WS_W_UP = 21 * MiB;
constexpr size_t WS_W_OUT = 25 * MiB;
constexpr size_t WS_W_GU = 33 * MiB;
constexpr size_t WS_W_DN = 77 * MiB;
constexpr size_t WS_W_PIN = 99 * MiB;
constexpr size_t WS_W_GRP = 107 * MiB;
constexpr size_t WS_W_POUT = 109 * MiB;
constexpr size_t WS_W_MGU = 117 * MiB;
constexpr size_t WS_W_MDN = 565 * MiB;
constexpr size_t WS_Y = 789 * MiB;
constexpr size_t WS_H3F = 855 * MiB;
constexpr size_t WS_RINFO = 921 * MiB;
constexpr size_t WS_TOKG = 921 * MiB + 512 * 1024;
constexpr size_t WS_OV = 922 * MiB;
constexpr size_t WS_L_CQKV = 922 * MiB;
constexpr size_t WS_L_KR = 939 * MiB;
constexpr size_t WS_L_LF = 941 * MiB + 512 * 1024;
constexpr size_t WS_L_QP = 942 * MiB;
constexpr size_t WS_L_KP = 992 * MiB;
constexpr size_t WS_L_VP = 1042 * MiB;
constexpr size_t WS_L_O = 1075 * MiB;
constexpr size_t WS_L_H1F = 1108 * MiB;
constexpr size_t WS_L_H1B = 1174 * MiB;
constexpr size_t WS_L_ACT = 1207 * MiB;
constexpr size_t WS_L_H2F = 1298 * MiB;
constexpr size_t WS_L_H2B = 1364 * MiB;
constexpr size_t WS_L_HP = 1397 * MiB;
constexpr size_t WS_L_PB = 1463 * MiB;
constexpr size_t WS_L_YP = 1496 * MiB;
constexpr size_t WS_L_H0B = 1529 * MiB;
constexpr size_t WS_END = 1562 * MiB;
constexpr size_t WS_M_XG = 922 * MiB;
constexpr size_t WS_M_ACT = 1178 * MiB;
constexpr int CW_TMO = 0, CW_CODE = 1, CW_BAR = 4096, CW_CNT = 8192;

constexpr int RING_BYTES = 151552;
constexpr int LDS_PSTAT = 131072;
constexpr int MISC_OFF = RING_BYTES;
constexpr int LDS_BYTES = 155648;

__device__ __forceinline__ unsigned cvt_pk_bf16(float lo, float hi) { unsigned r; asm volatile("v_cvt_pk_bf16_f32 %0, %1, %2" : "=v"(r) : "v"(lo), "v"(hi)); return r; }
__device__ __forceinline__ u32x4 pack8(f32x4 a, f32x4 b) { u32x4 w; w.x = cvt_pk_bf16(a[0], a[1]); w.y = cvt_pk_bf16(a[2], a[3]); w.z = cvt_pk_bf16(b[0], b[1]); w.w = cvt_pk_bf16(b[2], b[3]); return w; }
__device__ __forceinline__ u32x2 pack4(f32x4 a) { u32x2 w; w.x = cvt_pk_bf16(a[0], a[1]); w.y = cvt_pk_bf16(a[2], a[3]); return w; }
__device__ __forceinline__ float bf_lo(unsigned w) { return __uint_as_float(w << 16); }
__device__ __forceinline__ float bf_hi(unsigned w) { return __uint_as_float(w & 0xffff0000u); }
__device__ __forceinline__ float bf2f(bf16_t b) { return __uint_as_float(((unsigned)b) << 16); }
__device__ __forceinline__ bf16_t f2bf(float f) { return (bf16_t)(cvt_pk_bf16(f, 0.f) & 0xffffu); }
__device__ __forceinline__ float wave_sum(float v) {
#pragma unroll
    for (int o = 1; o < 64; o <<= 1) v += __shfl_xor(v, o);
    return v;
}
__device__ __forceinline__ float wave_max(float v) {
#pragma unroll
    for (int o = 1; o < 64; o <<= 1) v = fmaxf(v, __shfl_xor(v, o));
    return v;
}
__device__ __forceinline__ double wave_sum_d(double v) {
#pragma unroll
    for (int o = 1; o < 64; o <<= 1) v += __shfl_xor(v, o);
    return v;
}

#ifndef BG_IN_ATTN
#define BG_IN_ATTN 1
#endif
#ifndef BG_IN_PROLOGUE
#define BG_IN_PROLOGUE 0
#endif
#ifndef GEMM_SP2
#define GEMM_SP2 true
#endif
#ifndef EPI_TWICE
#define EPI_TWICE 0
#endif
#ifndef MOE_WGM
#define MOE_WGM 8
#endif
#ifndef FP8_EMU
#define FP8_EMU 0
#endif
__device__ __forceinline__ void q8pair(float& a, float& b, float sc) {
    float x = fminf(fmaxf(a * sc, -448.f), 448.f), y = fminf(fmaxf(b * sc, -448.f), 448.f);
    const int p = __builtin_amdgcn_cvt_pk_fp8_f32(x, y, 0, false); const float is = 1.0f / sc;
    a = __builtin_amdgcn_cvt_f32_fp8(p, 0) * is; b = __builtin_amdgcn_cvt_f32_fp8(p, 1) * is;
}
__device__ __forceinline__ f32x4 q8v(f32x4 v, float sc) { float a = v[0], b = v[1], c = v[2], d = v[3]; q8pair(a, b, sc); q8pair(c, d, sc); return (f32x4){a, b, c, d}; }
__device__ __forceinline__ unsigned pack4_fp8(float a, float b, float c, float d) {
    a = fminf(fmaxf(a, -448.f), 448.f); b = fminf(fmaxf(b, -448.f), 448.f); c = fminf(fmaxf(c, -448.f), 448.f); d = fminf(fmaxf(d, -448.f), 448.f);
    int p = __builtin_amdgcn_cvt_pk_fp8_f32(a, b, 0, false); p = __builtin_amdgcn_cvt_pk_fp8_f32(c, d, p, true); return (unsigned)p; }
typedef short s16x2_t __attribute__((ext_vector_type(2)));
__device__ __forceinline__ unsigned pack4_fp8_sc(float a, float b, float c, float d, float inv) {
    const s16x2_t lo = __builtin_amdgcn_cvt_scalef32_pk_fp8_f32((s16x2_t){0, 0}, a, b, inv, false);
    return __builtin_bit_cast(unsigned, __builtin_amdgcn_cvt_scalef32_pk_fp8_f32(lo, c, d, inv, true)); }
#define LDS_WAIT() asm volatile("s_waitcnt lgkmcnt(0)" ::: "memory")
#define VM_WAIT() asm volatile("s_waitcnt vmcnt(0)" ::: "memory")

namespace pg8 {
constexpr int BM = 256, BK = 64, HALF = 128, HTB = HALF * BK * 2, STAGE_BYTES = 8 * HTB, NXCD = 8, WGM = 8;
__host__ __device__ __forceinline__ int lds_byte(int r, int c) { const int st = (r >> 4) * 2 + (c >> 5), rr = r & 15, cc = c & 31, ob = rr * 64 + cc * 2; return st * 1024 + (ob ^ (((ob >> 9) & 1) << 5)); }
__host__ __device__ __forceinline__ void stage_rc(int b, int& Rr, int& C) { const int st = b / 1024, sb = b % 1024, swz = sb ^ (((sb >> 9) & 1) << 5); Rr = (st >> 1) * 16 + swz / 64; C = (st & 1) * 32 + (swz % 64) / 2; }
__host__ __device__ __forceinline__ int perm32(int rho) { const int n = rho >> 4, i = rho & 15; return 8 * (i >> 2) + 4 * n + (i & 3); }

struct Unit { int pm, pn, e, ks, nvalid, aux; const char* A; const char* B; };

__device__ __forceinline__ bool tile_order(int i, int G, int c, int nM, int nN, int& pm, int& pn) {
    const int nwg = nM * nN; const long L = (long)i * G + c; if (L >= nwg) return false;
    int wgid = (int)L; { const int q = nwg / NXCD, r = nwg % NXCD, xcd = wgid % NXCD, off = wgid / NXCD; wgid = (xcd < r ? xcd * (q + 1) : r * (q + 1) + (xcd - r) * q) + off; }
    const int nig = WGM * nN, gid = wgid / nig, fm = gid * WGM, gsz = (nM - fm) < WGM ? (nM - fm) : WGM;
    pm = fm + ((wgid % nig) % gsz); pn = (wgid % nig) / gsz; return true;
}
template <int KIND> struct DenseSched {
    int nM, nN, G, c, pm0; const char* A; const char* B; size_t a_tile, b_tile;
    __device__ __forceinline__ bool next(int i, Unit& u) const {
        int pm, pn; if (!tile_order(i, G, c, nM, nN, pm, pn)) return false;
        u.pm = pm + pm0; u.pn = pn; u.e = 0; u.ks = 0; u.nvalid = 256; u.aux = 0;
        size_t aoff = 0; if (KIND == 1) aoff = pn >= 6 ? 1024 : 0; if (KIND == 2) aoff = (size_t)(pn >> 1) * 1024;
        u.A = A + (size_t)(pm + pm0) * a_tile + aoff; u.B = B + (size_t)pn * b_tile; return true;
    }
};
template <int DOWN> struct MoeSched {
    const volatile LAS int* mt; int G, c, nNx; const char* A; const char* B; size_t a_row, b_exp, b_tile, ks_bytes;
    __device__ __forceinline__ int rd(int i) const { return __builtin_amdgcn_readfirstlane(mt[i]); }
    __device__ __forceinline__ bool next(int i, Unit& u) const {
        const int U = rd(24); const long L = (long)i * G + c; if (L >= U) return false;
        int idx = (int)L; { const int q = U / NXCD, r = U % NXCD, xcd = idx % NXCD, off = idx / NXCD; idx = (xcd < r ? xcd * (q + 1) : r * (q + 1) + (xcd - r) * q) + off; }
        int e = 0;
#pragma unroll
        for (int j = 1; j < 8; ++j) if (idx >= rd(16 + j)) e = j;
        constexpr int GM = MOE_WGM; const int l = idx - rd(16 + e), nM = rd(8 + e), nig = GM * nNx, gid = l / nig, fm = gid * GM, gsz = (nM - fm) < GM ? (nM - fm) : GM;
        const int pml = fm + ((l % nig) % gsz), jn = (l % nig) / gsz, pm = DOWN ? pml + rd(40 + e) : pml;
        u.pm = pm; u.e = e; u.nvalid = rd(e) - pm * 256; u.aux = DOWN ? rd(48 + e) + pml : 0;
        if (DOWN) { u.pn = jn & 7; u.ks = jn >> 3; u.A = A + (size_t)(rd(32 + e) + pm * 256) * a_row + (size_t)u.ks * ks_bytes; u.B = B + (size_t)e * b_exp + (size_t)u.pn * b_tile + (size_t)u.ks * ks_bytes; }
        else { u.pn = jn; u.ks = 0; u.A = A + (size_t)(e * CAP + pm * 256) * a_row; u.B = B + (size_t)e * b_exp + (size_t)jn * b_tile; }
        return true;
    }
};

typedef f32x4 Acc[2][2][4][2];
typedef int i32x8 __attribute__((ext_vector_type(8)));
typedef int i32x4 __attribute__((ext_vector_type(4)));
__device__ __forceinline__ i32x8 cat8(bf16x8 lo, bf16x8 hi) { const i32x4 a = __builtin_bit_cast(i32x4, lo), b = __builtin_bit_cast(i32x4, hi); return __builtin_shufflevector(a, b, 0, 1, 2, 3, 4, 5, 6, 7); }

typedef double f64x2 __attribute__((ext_vector_type(2)));
__device__ __forceinline__ f32x4 zero4() { f64x2 z; asm volatile("v_mov_b64 %0, 0" : "=v"(z.x)); asm volatile("v_mov_b64 %0, 0" : "=v"(z.y)); return __builtin_bit_cast(f32x4, z); }
template <bool FP8 = false, bool SP2 = GEMM_SP2, class Epi, class Sched>
__device__ __forceinline__ void gemm_phase(LAS unsigned char* lds, const int K, const int lda, const int ldb, const Sched& S, const Epi& E) {
    const int tid = threadIdx.x, wid = __builtin_amdgcn_readfirstlane(tid >> 6), lane = tid & 63, wr = wid >> 2, wc = wid & 3, fr = lane & 15, fq = lane >> 4;
    const int nt = K / BK;
    unsigned voffA[2], voffB[2];
#pragma unroll
    for (int i = 0; i < 2; ++i) { int Rr, C; stage_rc(tid * 16 + i * 8192, Rr, C); const int Rb = (Rr & ~31) + perm32(Rr & 31);
        voffA[i] = (unsigned)(Rr * lda + C) * 2u; voffB[i] = (unsigned)(Rb * ldb + C) * 2u; }
    const size_t kstep = (size_t)(BK * 2);
    const size_t hstepA = (size_t)HALF * lda * 2, hstepB = (size_t)HALF * ldb * 2;
    const unsigned ldsw = (unsigned)wid * 1024u;
    const int aoff = lds_byte(wr * 64 + fr, fq * 8), boff = lds_byte(wc * 32 + fr, fq * 8);
#define PG8_SA(b, h) (((b) * 2 + (h)) * HTB)
#define PG8_SB(b, h) ((4 + (b) * 2 + (h)) * HTB)
#define PG8_STAGE(bufoff, gbase, voff) do { _Pragma("unroll") for (int _i = 0; _i < 2; ++_i) \
        __builtin_amdgcn_global_load_lds((const unsigned*)((const char*)(gbase) + (voff)[_i]), (LAS unsigned*)(lds + (bufoff) + ldsw + _i * 8192), 16, 0, 0); } while (0)
#define PG8_LD8(p) __builtin_shufflevector(*(const LAS i32x4*)(p), *(const LAS i32x4*)((p) + 1024), 0, 1, 2, 3, 4, 5, 6, 7)
#define PG8_LDA(dst, b, h) do { if constexpr (FP8) { _Pragma("unroll") for (int m = 0; m < 4; ++m) dst##8[m] = PG8_LD8(lds + PG8_SA(b, h) + aoff + m * 2048); } \
        else { _Pragma("unroll") for (int m = 0; m < 4; ++m) _Pragma("unroll") for (int k = 0; k < 2; ++k) dst[m][k] = *(const LAS bf16x8*)(lds + PG8_SA(b, h) + aoff + m * 2048 + k * 1024); } } while (0)
#define PG8_LDB(dst, b, h) do { if constexpr (FP8) { _Pragma("unroll") for (int n = 0; n < 2; ++n) dst##8[n] = PG8_LD8(lds + PG8_SB(b, h) + boff + n * 2048); } \
        else { _Pragma("unroll") for (int n = 0; n < 2; ++n) _Pragma("unroll") for (int k = 0; k < 2; ++k) dst[n][k] = *(const LAS bf16x8*)(lds + PG8_SB(b, h) + boff + n * 2048 + k * 1024); } } while (0)
#define PG8_MMA(ai, bj, At, Bt) do { __builtin_amdgcn_s_setprio(1); _Pragma("unroll") for (int m = 0; m < 4; ++m) _Pragma("unroll") for (int n = 0; n < 2; ++n) { \
        if constexpr (FP8) asm volatile("v_mfma_scale_f32_16x16x128_f8f6f4 %0, %1, %2, %0, %3, %3 op_sel_hi:[0,0,0]" : "+v"(acc[ai][bj][m][n]) : "v"(Bt##8[n]), "v"(At##8[m]), "v"(one8)); \
        else { _Pragma("unroll") for (int k = 0; k < 2; ++k) acc[ai][bj][m][n] = __builtin_amdgcn_mfma_f32_16x16x32_bf16(Bt[n][k], At[m][k], acc[ai][bj][m][n], 0, 0, 0); } } __builtin_amdgcn_s_setprio(0); } while (0)
#define PG8_WAIT_V(n) asm volatile("s_waitcnt vmcnt(" #n ")" ::: "memory")
#define PG8_WAIT_L(n) asm volatile("s_waitcnt lgkmcnt(" #n ")" ::: "memory")
#define PG8_BAR __builtin_amdgcn_s_barrier()
#define PG8_SCHED __builtin_amdgcn_sched_barrier(0)
    Unit cur, nxt; int ui = 0;
    if (!S.next(0, cur)) return;
    Acc acc;
#pragma unroll
    for (int a = 0; a < 2; ++a)
#pragma unroll
        for (int b = 0; b < 2; ++b)
#pragma unroll
            for (int m = 0; m < 4; ++m)
#pragma unroll
                for (int n = 0; n < 2; ++n) acc[a][b][m][n] = (f32x4){0.f, 0.f, 0.f, 0.f};
    bf16x8 At[4][2], B0[2][2], B1[2][2];
    const int one8 = 0x7f7f7f7f;
    i32x8 At8[4], B08[2], B18[2];
    const char* cA = cur.A; const char* cB = cur.B;
    if constexpr (SP2) {
    PG8_STAGE(PG8_SB(0, 0), cB, voffB); PG8_STAGE(PG8_SB(0, 1), cB + hstepB, voffB); PG8_STAGE(PG8_SA(0, 0), cA, voffA); PG8_STAGE(PG8_SA(0, 1), cA + hstepA, voffA);
    if (wr == 1) PG8_BAR;
    PG8_WAIT_V(2); PG8_BAR;
    PG8_STAGE(PG8_SB(1, 0), cB + kstep, voffB); PG8_STAGE(PG8_SA(1, 0), cA + kstep, voffA); PG8_STAGE(PG8_SB(1, 1), cB + hstepB + kstep, voffB);
    PG8_WAIT_V(6); PG8_BAR;
    } else {
    PG8_STAGE(PG8_SB(0, 0), cB, voffB); PG8_STAGE(PG8_SA(0, 0), cA, voffA); PG8_STAGE(PG8_SB(0, 1), cB + hstepB, voffB); PG8_STAGE(PG8_SA(0, 1), cA + hstepA, voffA);
    if (wr == 1) PG8_BAR;
    PG8_WAIT_V(4); PG8_BAR;
    PG8_STAGE(PG8_SB(1, 0), cB + kstep, voffB); PG8_STAGE(PG8_SA(1, 0), cA + kstep, voffA); PG8_STAGE(PG8_SB(1, 1), cB + hstepB + kstep, voffB);
    PG8_WAIT_V(6); PG8_BAR;
    }
    for (;;) {
        const bool has_next = S.next(ui + 1, nxt);
        const char* nA = has_next ? nxt.A : cA; const char* nB = has_next ? nxt.B : cB;
        for (int t = 0; t < nt; t += 2) {
            const bool last = (t == nt - 2);
            const char* a1 = cA + (size_t)(t + 1) * kstep;
            const char* a2 = last ? nA : cA + (size_t)(t + 2) * kstep; const char* b2 = last ? nB : cB + (size_t)(t + 2) * kstep;
            const char* a3 = a2 + kstep; const char* b3 = b2 + kstep;
            if constexpr (SP2) {
            PG8_LDB(B0, 0, 0); PG8_LDB(B1, 0, 1); PG8_SCHED; PG8_LDA(At, 0, 0); PG8_STAGE(PG8_SA(1, 1), a1 + hstepA, voffA);
            PG8_WAIT_V(8); PG8_WAIT_L(0); PG8_BAR; PG8_MMA(0, 0, At, B0); PG8_MMA(0, 1, At, B1); PG8_BAR; PG8_SCHED;
            PG8_LDA(At, 0, 1); PG8_STAGE(PG8_SB(0, 0), b2, voffB); PG8_STAGE(PG8_SB(0, 1), b2 + hstepB, voffB); PG8_STAGE(PG8_SA(0, 0), a2, voffA);
            PG8_WAIT_V(8); PG8_WAIT_L(0); PG8_BAR; PG8_MMA(1, 0, At, B0); PG8_MMA(1, 1, At, B1); PG8_BAR; PG8_SCHED;
            PG8_LDB(B0, 1, 0); PG8_LDB(B1, 1, 1); PG8_SCHED; PG8_LDA(At, 1, 0); PG8_STAGE(PG8_SA(0, 1), a2 + hstepA, voffA);
            PG8_WAIT_V(8); PG8_WAIT_L(0); PG8_BAR; PG8_MMA(0, 0, At, B0); PG8_MMA(0, 1, At, B1); PG8_BAR; PG8_SCHED;
            PG8_LDA(At, 1, 1); PG8_STAGE(PG8_SB(1, 0), b3, voffB); PG8_STAGE(PG8_SB(1, 1), b3 + hstepB, voffB); PG8_STAGE(PG8_SA(1, 0), a3, voffA);
            PG8_WAIT_V(8); PG8_WAIT_L(0); PG8_BAR; PG8_MMA(1, 0, At, B0); PG8_MMA(1, 1, At, B1); PG8_BAR; PG8_SCHED;
            } else {
            PG8_LDB(B0, 0, 0); PG8_SCHED; PG8_LDA(At, 0, 0); PG8_STAGE(PG8_SA(1, 1), a1 + hstepA, voffA);
            PG8_WAIT_L(8); PG8_BAR; PG8_WAIT_L(0); PG8_MMA(0, 0, At, B0); PG8_BAR; PG8_SCHED;
            PG8_LDB(B1, 0, 1); PG8_STAGE(PG8_SB(0, 0), b2, voffB);
            PG8_BAR; PG8_WAIT_L(0); PG8_MMA(0, 1, At, B1); PG8_BAR;
            PG8_LDA(At, 0, 1); PG8_STAGE(PG8_SA(0, 0), a2, voffA);
            PG8_BAR; PG8_WAIT_L(0); PG8_MMA(1, 0, At, B0); PG8_BAR; PG8_SCHED;
            PG8_STAGE(PG8_SB(0, 1), b2 + hstepB, voffB);
            PG8_WAIT_V(6); PG8_BAR; PG8_MMA(1, 1, At, B1); PG8_BAR;
            PG8_LDB(B0, 1, 0); PG8_SCHED; PG8_LDA(At, 1, 0); PG8_STAGE(PG8_SA(0, 1), a2 + hstepA, voffA);
            PG8_WAIT_L(8); PG8_BAR; PG8_WAIT_L(0); PG8_MMA(0, 0, At, B0); PG8_BAR; PG8_SCHED;
            PG8_LDB(B1, 1, 1); PG8_STAGE(PG8_SB(1, 0), b3, voffB);
            PG8_BAR; PG8_WAIT_L(0); PG8_MMA(0, 1, At, B1); PG8_BAR;
            PG8_LDA(At, 1, 1); PG8_STAGE(PG8_SA(1, 0), a3, voffA);
            PG8_BAR; PG8_WAIT_L(0); PG8_MMA(1, 0, At, B0); PG8_BAR; PG8_SCHED;
            PG8_STAGE(PG8_SB(1, 1), b3 + hstepB, voffB);
            PG8_WAIT_V(6); PG8_BAR; PG8_MMA(1, 1, At, B1); PG8_BAR;
            }
        }
        if constexpr (FP8) asm volatile("s_nop 15\n\ts_nop 15" ::: "memory");
        if (wr == 0) PG8_BAR;
        { int fr2 = fr, fq2 = fq; asm volatile("" : "+v"(fr2), "+v"(fq2)); E(acc, cur, wr, wc, fr2, fq2); if constexpr (FP8 && EPI_TWICE) { asm volatile("" : "+v"(fr2), "+v"(fq2)); E(acc, cur, wr, wc, fr2, fq2); } }
        if (!has_next) break;
#pragma unroll
        for (int a = 0; a < 2; ++a)
#pragma unroll
            for (int b = 0; b < 2; ++b)
#pragma unroll
                for (int m = 0; m < 4; ++m)
#pragma unroll
                    for (int n = 0; n < 2; ++n) acc[a][b][m][n] = zero4();
        cur = nxt; cA = nA; cB = nB; ++ui;
        if (wr == 1) PG8_BAR;
    }
    PG8_WAIT_V(0);
    PG8_BAR;
#undef PG8_SA
#undef PG8_SB
#undef PG8_STAGE
#undef PG8_LDA
#undef PG8_LD8
#undef PG8_LDB
#undef PG8_MMA
#undef PG8_WAIT_V
#undef PG8_WAIT_L
#undef PG8_BAR
#undef PG8_SCHED
}

#define EPI_ROWS _Pragma("unroll") for (int ai = 0; ai < 2; ++ai) _Pragma("unroll") for (int m = 0; m < 4; ++m)
#define EPI_RL (ai * 128 + wr * 64 + m * 16 + fr)

struct EpiIn {
    unsigned char* ws; const float* fbias;
    __device__ __forceinline__ void operator()(const Acc& acc, const Unit& u, int wr, int wc, int fr, int fq) const {
        const int pn = u.pn, c8 = wc * 32 + fq * 8;
        bf16_t* cqkv = (bf16_t*)(ws + WS_L_CQKV); float* ssq = (float*)(ws + WS_SSQ); float* kr = (float*)(ws + WS_L_KR); float* lf = (float*)(ws + WS_L_LF);
        if (pn < 4) {
            EPI_ROWS { const int row = u.pm * 256 + EPI_RL; float s = 0.f;
#pragma unroll
                for (int bj = 0; bj < 2; ++bj) { const f32x4 v0 = acc[ai][bj][m][0], v1 = acc[ai][bj][m][1];
                    *(u32x4*)(cqkv + (size_t)row * 1024 + pn * 256 + bj * 128 + c8) = pack8(v0, v1);
                    float t = v0[0] * v0[0] + v0[1] * v0[1] + v0[2] * v0[2] + v0[3] * v0[3] + v1[0] * v1[0] + v1[1] * v1[1] + v1[2] * v1[2] + v1[3] * v1[3];
                    t += __shfl_xor(t, 16); t += __shfl_xor(t, 32); s += t; }
                if (fq == 0) ssq[((size_t)(pn >> 1) * R + row) * 8 + (pn & 1) * 4 + wc] = s; }
        } else if (pn < 16) {
            const size_t toff = pn < 8 ? WS_L_QP : (pn < 12 ? WS_L_KP : WS_L_VP); bf16_t* T = (bf16_t*)(ws + toff); const int t = (pn - 4) & 3, width = pn < 12 ? DKP : DV; const float sc = pn < 8 ? QS_FOX : 1.f;
            EPI_ROWS { const int row = u.pm * 256 + EPI_RL;
#pragma unroll
                for (int bj = 0; bj < 2; ++bj) { const int head = 8 + 2 * t + bj;
                    *(u32x4*)(T + ((size_t)head * R + row) * width + c8) = pack8(acc[ai][bj][m][0] * sc, acc[ai][bj][m][1] * sc); } }
        } else {
            EPI_ROWS { const int row = u.pm * 256 + EPI_RL; const f32x4 v0 = acc[ai][0][m][0], v1 = acc[ai][0][m][1];
                if (wc < 2) { *(f32x4*)(kr + (size_t)row * 64 + c8) = v0; *(f32x4*)(kr + (size_t)row * 64 + c8 + 4) = v1; }
                else if (wc == 2 && fq == 0) { f32x4 o0, o1;
#pragma unroll
                    for (int j = 0; j < 4; ++j) { const float x0 = v0[j] + fbias[j], x1 = v1[j] + fbias[4 + j];
                        o0[j] = fminf(x0, 0.f) - log1pf(expf(-fabsf(x0))); o1[j] = fminf(x1, 0.f) - log1pf(expf(-fabsf(x1))); }
                    *(f32x4*)(lf + (size_t)row * 8) = o0; *(f32x4*)(lf + (size_t)row * 8 + 4) = o1; } }
        }
    }
};
struct EpiUp {
    const float* ssq; const float* cs; bf16_t *qp, *kp, *vp;
    __device__ __forceinline__ void operator()(const Acc& acc, const Unit& u, int wr, int wc, int fr, int fq) const {
        const int pn = u.pn, c8 = wc * 32 + fq * 8, which = pn < 6 ? 0 : 1;
        EPI_ROWS { const int row = u.pm * 256 + EPI_RL;
            const f32x4 s0 = *(const f32x4*)(ssq + ((size_t)which * R + row) * 8), s1 = *(const f32x4*)(ssq + ((size_t)which * R + row) * 8 + 4);
            const float ss = ((s0[0] + s0[1]) + (s0[2] + s0[3])) + ((s1[0] + s1[1]) + (s1[2] + s1[3]));
            const float rr = 1.0f / sqrtf(ss * (1.0f / 512.0f) + RMS_EPS);
            if (pn < 4) { const float sc = rr * QS_MLA;
#pragma unroll
                for (int bj = 0; bj < 2; ++bj) *(u32x4*)(qp + ((size_t)(2 * pn + bj) * R + row) * DKP + c8) = pack8(acc[ai][bj][m][0] * sc, acc[ai][bj][m][1] * sc);
            } else if (pn < 6) { const float sc = rr * QS_MLA; const int q8 = 4 * (wc & 1) + fq;
                const f32x4 C = *(const f32x4*)(cs + (size_t)row * 64 + 4 * q8), Sn = *(const f32x4*)(cs + (size_t)row * 64 + 32 + 4 * q8);
#pragma unroll
                for (int bj = 0; bj < 2; ++bj) { const int head = 4 * (pn - 4) + 2 * bj + (wc >> 1); const f32x4 x1 = acc[ai][bj][m][0] * sc, x2 = acc[ai][bj][m][1] * sc;
                    bf16_t* q = qp + ((size_t)head * R + row) * DKP + 128 + 4 * q8;
                    *(u32x2*)q = pack4(x1 * C - x2 * Sn); *(u32x2*)(q + 32) = pack4(x2 * C + x1 * Sn); }
            } else if (pn < 10) {
#pragma unroll
                for (int bj = 0; bj < 2; ++bj) *(u32x4*)(kp + ((size_t)(2 * (pn - 6) + bj) * R + row) * DKP + c8) = pack8(acc[ai][bj][m][0] * rr, acc[ai][bj][m][1] * rr);
            } else {
#pragma unroll
                for (int bj = 0; bj < 2; ++bj) *(u32x4*)(vp + ((size_t)(2 * (pn - 10) + bj) * R + row) * DV + c8) = pack8(acc[ai][bj][m][0] * rr, acc[ai][bj][m][1] * rr);
            }
        }
    }
};
template <int MODE> struct EpiRes {
    float* Y; const float* stats; const float* x; const float* meta; const float* g; const float* b;
    __device__ __forceinline__ void operator()(const Acc& acc, const Unit& u, int wr, int wc, int fr, int fq) const {
        const int c8 = wc * 32 + fq * 8;
        EPI_ROWS { const int row = u.pm * 256 + EPI_RL;
            const float* rp; float mean = 0.f, rstd = 0.f;
            if (MODE == 1) { rp = Y + (size_t)row * DM; const f32x2 st = *(const f32x2*)(stats + (size_t)row * 2); mean = st.x; rstd = st.y; }
            else rp = row >= ROW0 ? x + (size_t)(row - ROW0) * DM : (row >= PADR ? meta + (size_t)(row - PADR) * DM : nullptr);
#pragma unroll
            for (int bj = 0; bj < 2; ++bj) { const int col = u.pn * 256 + bj * 128 + c8;
                f32x4 r0 = (f32x4){0.f, 0.f, 0.f, 0.f}, r1 = r0; if (MODE == 1 || rp) { r0 = *(const f32x4*)(rp + col); r1 = *(const f32x4*)(rp + col + 4); }
                if (MODE == 1) {
                    r0 = (r0 - mean) * rstd * *(const f32x4*)(g + col) + *(const f32x4*)(b + col); r1 = (r1 - mean) * rstd * *(const f32x4*)(g + col + 4) + *(const f32x4*)(b + col + 4); }
                *(f32x4*)(Y + (size_t)row * DM + col) = r0 * ALPHA + acc[ai][bj][m][0]; *(f32x4*)(Y + (size_t)row * DM + col + 4) = r1 * ALPHA + acc[ai][bj][m][1]; }
        }
    }
};
struct EpiResStat {
    float* Y; const float* stats; const float* g; const float* b; bf16_t* Y16; float* slots; LAS unsigned char* lds;
    __device__ __forceinline__ void operator()(const Acc& acc, const Unit& u, int wr, int wc, int fr, int fq) const {
        const int c8 = wc * 32 + fq * 8; LAS f32x2* P = (LAS f32x2*)(lds + LDS_PSTAT);
        EPI_ROWS { const int rl = EPI_RL, row = u.pm * 256 + rl; float* rp = Y + (size_t)row * DM; const f32x2 st = *(const f32x2*)(stats + (size_t)row * 2); float sm = 0.f, sq = 0.f;
#pragma unroll
            for (int bj = 0; bj < 2; ++bj) { const int col = u.pn * 256 + bj * 128 + c8;
                f32x4 r0 = *(const f32x4*)(rp + col), r1 = *(const f32x4*)(rp + col + 4);
                r0 = (r0 - st.x) * st.y * *(const f32x4*)(g + col) + *(const f32x4*)(b + col); r1 = (r1 - st.x) * st.y * *(const f32x4*)(g + col + 4) + *(const f32x4*)(b + col + 4);
                const f32x4 y0 = r0 * ALPHA + acc[ai][bj][m][0], y1 = r1 * ALPHA + acc[ai][bj][m][1];
                *(f32x4*)(rp + col) = y0; *(f32x4*)(rp + col + 4) = y1; *(u32x4*)(Y16 + (size_t)row * DM + col) = pack8(y0, y1);
                sm += ((y0[0] + y0[1]) + (y0[2] + y0[3])) + ((y1[0] + y1[1]) + (y1[2] + y1[3]));
                sq += ((y0[0] * y0[0] + y0[1] * y0[1]) + (y0[2] * y0[2] + y0[3] * y0[3])) + ((y1[0] * y1[0] + y1[1] * y1[1]) + (y1[2] * y1[2] + y1[3] * y1[3])); }
            sm += __shfl_xor(sm, 16); sm += __shfl_xor(sm, 32); sq += __shfl_xor(sq, 16); sq += __shfl_xor(sq, 32);
            if (fq == 0) P[rl * 4 + wc] = (f32x2){sm, sq}; }
        asm volatile("s_waitcnt lgkmcnt(0)" ::: "memory"); __builtin_amdgcn_s_barrier(); asm volatile("" ::: "memory");
        const int t = threadIdx.x;
        if (t < 256) { const f32x2 a = P[t * 4 + 0], bb = P[t * 4 + 1], c = P[t * 4 + 2], d = P[t * 4 + 3];
            *(f32x2*)(slots + ((size_t)(u.pm * 256 + t) * 8 + u.pn) * 2) = (f32x2){(a.x + bb.x) + (c.x + d.x), (a.y + bb.y) + (c.y + d.y)}; }
    }
};
struct EpiPoolIn {
    bf16_t* HP; const float* slots; const float* c1; const float* c2; float* stats;
    __device__ __forceinline__ void operator()(const Acc& acc, const Unit& u, int wr, int wc, int fr, int fq) const {
        const int c8 = wc * 32 + fq * 8;
        EPI_ROWS { const int row = u.pm * 256 + EPI_RL; const f32x4* sp = (const f32x4*)(slots + (size_t)row * 16); const f32x4 a = sp[0], bb = sp[1], c = sp[2], d = sp[3];
            const float S = ((a[0] + a[2]) + (bb[0] + bb[2])) + ((c[0] + c[2]) + (d[0] + d[2])), Q = ((a[1] + a[3]) + (bb[1] + bb[3])) + ((c[1] + c[3]) + (d[1] + d[3]));
            const float mean = S * (1.0f / DM), var = Q * (1.0f / DM) - mean * mean, rstd = 1.0f / sqrtf(var + LN_EPS);
            if (u.pn == 0 && wc == 0 && fq == 0) *(f32x2*)(stats + (size_t)row * 2) = (f32x2){mean, rstd};
#pragma unroll
            for (int bj = 0; bj < 2; ++bj) { const int col = u.pn * 256 + bj * 128 + c8;
                const f32x4 v0 = (acc[ai][bj][m][0] - *(const f32x4*)(c1 + col) * mean) * rstd + *(const f32x4*)(c2 + col);
                const f32x4 v1 = (acc[ai][bj][m][1] - *(const f32x4*)(c1 + col + 4) * mean) * rstd + *(const f32x4*)(c2 + col + 4);
                *(u32x4*)(HP + (size_t)row * DM + col) = pack8(v0, v1); } }
    }
};
__device__ __forceinline__ float silu_mul(float g, float uu) { return g * __builtin_amdgcn_rcpf(1.0f + __builtin_amdgcn_exp2f(-g * LOG2E)) * uu; }
__device__ __forceinline__ f32x4 silu_mul4(f32x4 g, f32x4 uu, float cg, float cu) {
    const f32x4 t = g * (-cg * LOG2E); f32x4 e;
    e[0] = __builtin_amdgcn_exp2f(t[0]); e[1] = __builtin_amdgcn_exp2f(t[1]); e[2] = __builtin_amdgcn_exp2f(t[2]); e[3] = __builtin_amdgcn_exp2f(t[3]);
    const f32x4 sden = e + 1.0f; f32x4 r;
    r[0] = __builtin_amdgcn_rcpf(sden[0]); r[1] = __builtin_amdgcn_rcpf(sden[1]); r[2] = __builtin_amdgcn_rcpf(sden[2]); r[3] = __builtin_amdgcn_rcpf(sden[3]);
    return (g * uu) * (r * (cg * cu));
}
__device__ __forceinline__ f32x4 silu_mul4_raw(f32x4 g, f32x4 uu, float kt) {
    const f32x4 t = g * kt; f32x4 e;
    e[0] = __builtin_amdgcn_exp2f(t[0]); e[1] = __builtin_amdgcn_exp2f(t[1]); e[2] = __builtin_amdgcn_exp2f(t[2]); e[3] = __builtin_amdgcn_exp2f(t[3]);
    const f32x4 sden = e + 1.0f; f32x4 r;
    r[0] = __builtin_amdgcn_rcpf(sden[0]); r[1] = __builtin_amdgcn_rcpf(sden[1]); r[2] = __builtin_amdgcn_rcpf(sden[2]); r[3] = __builtin_amdgcn_rcpf(sden[3]);
    return (g * uu) * r;
}
struct EpiGU {
    bf16_t* act; int ld;
    __device__ __forceinline__ void operator()(const Acc& acc, const Unit& u, int wr, int wc, int fr, int fq) const {
        const int c8 = wc * 32 + fq * 8; const int rbase = u.pm * 256;
        EPI_ROWS { const int row = rbase + EPI_RL; const f32x4 g0 = acc[ai][0][m][0], g1 = acc[ai][0][m][1], u0 = acc[ai][1][m][0], u1 = acc[ai][1][m][1]; f32x4 a0, a1;
            a0 = silu_mul4(g0, u0, 1.0f, 1.0f); a1 = silu_mul4(g1, u1, 1.0f, 1.0f);
            if (FP8_EMU) { a0 = q8v(a0, 4.f); a1 = q8v(a1, 4.f); }
            *(u32x4*)(act + (size_t)row * ld + u.pn * 128 + c8) = pack8(a0, a1); }
    }
};
struct EpiGU8 {
    unsigned char* act; const volatile LAS int* mt;
    __device__ __forceinline__ void operator()(const Acc& acc, const Unit& u, int wr, int wc, int fr, int fq) const {
        const int c8 = wc * 32 + fq * 8; const int rbase = __builtin_amdgcn_readfirstlane(mt[32 + u.e]) + u.pm * 256; constexpr float IS = 1.0f / (SX8 * SWGU8);
        EPI_ROWS { const int row = rbase + EPI_RL;
            const f32x4 a0 = silu_mul4_raw(acc[ai][0][m][0], acc[ai][1][m][0], -IS * LOG2E), a1 = silu_mul4_raw(acc[ai][0][m][1], acc[ai][1][m][1], -IS * LOG2E);
            constexpr float OS = 1.0f / (IS * IS * SACT8);
            u32x2 o; o.x = pack4_fp8_sc(a0[0], a0[1], a0[2], a0[3], OS); o.y = pack4_fp8_sc(a1[0], a1[1], a1[2], a1[3], OS);
            *(u32x2*)(act + (size_t)row * FE + u.pn * 128 + c8) = o; }
    }
};
struct EpiF32 { float* C;
    __device__ __forceinline__ void operator()(const Acc& acc, const Unit& u, int wr, int wc, int fr, int fq) const {
        const int c8 = wc * 32 + fq * 8;
        EPI_ROWS { const int row = u.pm * 256 + EPI_RL;
#pragma unroll
            for (int bj = 0; bj < 2; ++bj) { float* p = C + (size_t)row * DM + u.pn * 256 + bj * 128 + c8; *(f32x4*)p = acc[ai][bj][m][0]; *(f32x4*)(p + 4) = acc[ai][bj][m][1]; } }
    }
};
struct EpiBf { bf16_t* C;
    __device__ __forceinline__ void operator()(const Acc& acc, const Unit& u, int wr, int wc, int fr, int fq) const {
        const int c8 = wc * 32 + fq * 8;
        EPI_ROWS { const int row = u.pm * 256 + EPI_RL;
#pragma unroll
            for (int bj = 0; bj < 2; ++bj) *(u32x4*)(C + (size_t)row * DM + u.pn * 256 + bj * 128 + c8) = pack8(acc[ai][bj][m][0], acc[ai][bj][m][1]); }
    }
};
struct EpiMoeDown { bf16_t* ym; bf16_t* yx; const int* rinfo;
    __device__ __forceinline__ void operator()(const Acc& acc, const Unit& u, int wr, int wc, int fr, int fq) const {
        const int c8 = wc * 32 + fq * 8;
        EPI_ROWS { const int rl = EPI_RL;
            if (rl < u.nvalid) { bf16_t* p;
                if (u.ks == 0) { const int info = rinfo[u.e * CAP + u.pm * 256 + rl]; const int tok = info >> 1, k = info & 1; p = ym + ((size_t)k * SEQ + tok) * DM + u.pn * 256 + c8; }
                else p = yx + ((size_t)(u.ks - 1) * OVF_ROWS + u.aux * 256 + rl) * DM + u.pn * 256 + c8;
#pragma unroll
                for (int bj = 0; bj < 2; ++bj) *(u32x4*)(p + bj * 128) = pack8(acc[ai][bj][m][0] * (1.0f / (SACT8 * SWDN8)), acc[ai][bj][m][1] * (1.0f / (SACT8 * SWDN8))); } }
    }
};
}

#define XB_TMO      128
#define XB_XCNT(j)  (256  + 64 * (j))
#define XB_XSUB(j)  (1280 + 64 * (j))
#define XB_XGEN(j)  (2304 + 64 * (j))
#define XB_TOP      3328
#define XB_TOPGEN   3392
#define XCD_BAR_WORDS 3456
#define XB_SPIN_CAP (1u << 24)
__device__ __forceinline__ unsigned xb_ld(unsigned* p)              { return __hip_atomic_load(p, __ATOMIC_RELAXED, __HIP_MEMORY_SCOPE_AGENT); }
__device__ __forceinline__ unsigned xb_add(unsigned* p, unsigned v) { return __hip_atomic_fetch_add(p, v, __ATOMIC_RELAXED, __HIP_MEMORY_SCOPE_AGENT); }
__device__ __forceinline__ unsigned xb_xcc_id() { return (unsigned)__builtin_amdgcn_s_getreg((3 << 11) | 20) & 0xFu; }
#define XB_SPIN(cond, bar) do { unsigned _sp = 0; while (cond) { __builtin_amdgcn_s_sleep(1); \
    if ((++_sp & 255u) == 0u) { if (xb_ld(&(bar)[XB_TMO])) break; if (_sp > XB_SPIN_CAP) { atomicAdd(&(bar)[XB_TMO], 1u); break; } } } } while (0)
struct XcdBarrier { unsigned* bar; unsigned x; volatile LAS unsigned* st; };
__device__ __forceinline__ XcdBarrier xcd_barrier_post(unsigned* bar, volatile LAS unsigned* st) {
    XcdBarrier b; b.bar = bar; b.x = xb_xcc_id(); b.st = st;
    if (threadIdx.x == 0) (void)xb_add(&bar[XB_XCNT(b.x)], 1u);
    return b;
}
__device__ __forceinline__ void xcd_barrier_complete(unsigned* bar, unsigned x, unsigned& nloc, unsigned& nx) {
    const unsigned G = gridDim.x * gridDim.y * gridDim.z;
    unsigned sum, cnt, mine, sp = 0u;
    for (;;) {
        sum = 0u; cnt = 0u; mine = 0u;
#pragma unroll
        for (unsigned j = 0; j < 16; ++j) { const unsigned c = xb_ld(&bar[XB_XCNT(j)]); sum += c; cnt += (c > 0u) ? 1u : 0u; mine = (j == x) ? c : mine; }
        if (sum == G) break;
        __builtin_amdgcn_s_sleep(1);
        if ((++sp & 255u) == 0u) { if (xb_ld(&bar[XB_TMO])) break; if (sp > XB_SPIN_CAP) { atomicAdd(&bar[XB_TMO], 1u); break; } }
    }
    nloc = mine > 0u ? mine : 1u; nx = cnt > 0u ? cnt : 1u;
}
__device__ __forceinline__ void xcd_barrier(const XcdBarrier& b) {
    asm volatile("s_waitcnt vmcnt(0)" ::: "memory");
    __syncthreads();
    if (threadIdx.x == 0) {
        unsigned* bar = b.bar;
        __builtin_amdgcn_s_waitcnt(0);
        unsigned nloc = b.st[0], nx = b.st[1];
        if (nloc == 0u) { xcd_barrier_complete(bar, b.x, nloc, nx); b.st[0] = nloc; b.st[1] = nx; }
        const unsigned old = xb_add(&bar[XB_XSUB(b.x)], 1u);
        const unsigned gen = old / nloc;
        if (old + 1u == (gen + 1u) * nloc) {
            __builtin_amdgcn_fence(__ATOMIC_RELEASE, "agent");
            asm volatile("s_waitcnt vmcnt(0)" ::: "memory");
            const unsigned og = xb_add(&bar[XB_TOP], 1u);
            const unsigned tg = og / nx;
            if (og + 1u == (tg + 1u) * nx) xb_add(&bar[XB_TOPGEN], 1u);
            else XB_SPIN(xb_ld(&bar[XB_TOPGEN]) == tg, bar);
            __builtin_amdgcn_fence(__ATOMIC_ACQUIRE, "agent");
            xb_add(&bar[XB_XGEN(b.x)], 1u);
            asm volatile("s_waitcnt vmcnt(0)" ::: "memory");
        } else {
            XB_SPIN(xb_ld(&bar[XB_XGEN(b.x)]) == gen, bar);
            __builtin_amdgcn_fence(__ATOMIC_ACQUIRE, "agent");
            asm volatile("s_waitcnt vmcnt(0)" ::: "memory");
        }
    }
    __syncthreads();
}

struct Args { const float* in[25]; float* out; unsigned char* ws; int ph_lo, ph_hi; };
enum { I_X = 0, I_META, I_WIN, I_FBIAS, I_QNORM, I_KVNORM, I_WUQ, I_WUKV, I_WOUT, I_PWIN, I_PWGRP, I_PSCALE, I_PWOUT, I_FGATE, I_FUP, I_FDOWN, I_MROUTER, I_MBROUTER,
       I_MGATE, I_MUP, I_MDOWN, I_LNMG, I_LNMB, I_LNFG, I_LNFB };
struct Frame {
    LAS unsigned char* lds; volatile LAS int* MISC; unsigned* ctl; unsigned char* ws;
    int tid, lane, wave, vcu, G;
};
constexpr int NPHASE = 17;

enum { TK_PLAIN = 0, TK_IN, TK_UQ, TK_UKV, TK_GU };
__device__ __forceinline__ int t_srccol(int kind, int n) {
    switch (kind) {
        case TK_IN: return n < 1024 ? n : (n < 4096 ? n + 64 : (n < 4160 ? n - 3072 : (n < 4168 ? n : -1)));
        case TK_UQ: { if (n < 1024) return (n >> 7) * 192 + (n & 127); const int mm = n - 1024, h = mm >> 6, jj = mm & 63, q8 = jj >> 3, i = jj & 7;
                      return h * 192 + 128 + (i < 4 ? 4 * q8 + i : 32 + 4 * q8 + i - 4); }
        case TK_UKV: { if (n < 1024) return (n >> 7) * 256 + (n & 127); const int mm = n - 1024; return (mm >> 7) * 256 + 128 + (mm & 127); }
        case TK_GU: { const int p = n >> 8, r = n & 255; return 128 * p + (r & 127); }
        default: return n;
    }
}
struct TD { const float* W; const float* W2; const float* ksc; const float* nsc; bf16_t* WT; int K, Nsrc, kind, k0, n0, fp8; float wsc, q8; };
__device__ __forceinline__ void t_load(const TD& d, int lane, f32x2 (&v)[32]) {
    const int nd = d.n0 + 2 * (lane & 31); const int sc = t_srccol(d.kind, nd);
    const float* Ws = (d.kind == TK_GU && (nd & 128)) ? d.W2 : d.W;
    const float* p = Ws + (size_t)(d.k0 + (lane >> 5)) * d.Nsrc + (sc >= 0 ? sc : 0);
#pragma unroll
    for (int i = 0; i < 32; ++i) { v[i] = (f32x2){0.f, 0.f}; if (sc >= 0) v[i] = *(const f32x2*)(p + (size_t)(2 * i) * d.Nsrc); }
}
__device__ __forceinline__ void t_to_lds(int lane, const f32x2 (&v)[32], LAS float* scr) {
#pragma unroll
    for (int i = 0; i < 32; ++i) { const int kk = 2 * i + (lane >> 5); scr[kk * 65 + 2 * (lane & 31)] = v[i].x; scr[kk * 65 + 2 * (lane & 31) + 1] = v[i].y; }
}
__device__ __forceinline__ void t_store(const TD& d, int lane, LAS float* scr) {
    const int c = lane & 7;
    f32x4 ks0 = (f32x4){1.f, 1.f, 1.f, 1.f}, ks1 = ks0; if (d.ksc) { ks0 = *(const f32x4*)(d.ksc + d.k0 + 8 * c); ks1 = *(const f32x4*)(d.ksc + d.k0 + 8 * c + 4); }
#pragma unroll
    for (int j = 0; j < 8; ++j) { const int n = (lane >> 3) + 8 * j; const LAS float* s = scr + (8 * c) * 65 + n; const float ns = d.nsc ? d.nsc[d.n0 + n] : 1.f;
        f32x4 x0 = (f32x4){s[0 * 65], s[1 * 65], s[2 * 65], s[3 * 65]} * ks0 * ns, x1 = (f32x4){s[4 * 65], s[5 * 65], s[6 * 65], s[7 * 65]} * ks1 * ns;
        if (FP8_EMU && d.q8 > 0.f) { x0 = q8v(x0, d.q8); x1 = q8v(x1, d.q8); }
        *(u32x4*)(d.WT + (size_t)(d.n0 + n) * d.K + d.k0 + 8 * c) = pack8(x0, x1); }
}
__device__ __forceinline__ void t_load8(const TD& d, int lane, f32x2 (&v)[32]) {
    const int nd = d.n0 + 2 * (lane & 15); const int sc = t_srccol(d.kind, nd);
    const float* Ws = (d.kind == TK_GU && (nd & 128)) ? d.W2 : d.W;
    const float* p = Ws + (size_t)(d.k0 + (lane >> 4)) * d.Nsrc + sc;
#pragma unroll
    for (int i = 0; i < 32; ++i) v[i] = *(const f32x2*)(p + (size_t)(4 * i) * d.Nsrc);
}
__device__ __forceinline__ void t_to_lds8(int lane, const f32x2 (&v)[32], LAS float* scr) {
#pragma unroll
    for (int i = 0; i < 32; ++i) { const int kk = 4 * i + (lane >> 4); scr[kk * 33 + 2 * (lane & 15)] = v[i].x; scr[kk * 33 + 2 * (lane & 15) + 1] = v[i].y; }
}
__device__ __forceinline__ void t_store8(const TD& d, int lane, LAS float* scr) {
    const int c = lane & 7; unsigned char* WT8 = (unsigned char*)d.WT; const float ws = d.wsc;
#pragma unroll
    for (int j = 0; j < 4; ++j) { const int n = (lane >> 3) + 8 * j; const LAS float* s = scr + (16 * c) * 33 + n;
        u32x4 o; o.x = pack4_fp8(s[0 * 33] * ws, s[1 * 33] * ws, s[2 * 33] * ws, s[3 * 33] * ws); o.y = pack4_fp8(s[4 * 33] * ws, s[5 * 33] * ws, s[6 * 33] * ws, s[7 * 33] * ws);
        o.z = pack4_fp8(s[8 * 33] * ws, s[9 * 33] * ws, s[10 * 33] * ws, s[11 * 33] * ws); o.w = pack4_fp8(s[12 * 33] * ws, s[13 * 33] * ws, s[14 * 33] * ws, s[15 * 33] * ws);
        *(u32x4*)(WT8 + (size_t)(d.n0 + n) * d.K + d.k0 + 16 * c) = o; }
}

constexpr int BG_PER_EXPERT = 32 * 448, BG_GU_ITEMS = 8 * BG_PER_EXPERT;
constexpr int BG_DN_PER_EXPERT = 112 * 64, BG_DN_ITEMS = 31360;
constexpr int BG_FGU_ITEMS = 32 * 352, BG_FDN_ITEMS = 88 * 64;
constexpr int BG_J1 = BG_GU_ITEMS + BG_DN_ITEMS, BG_J2 = BG_J1 + BG_FGU_ITEMS, BG_ITEMS = BG_J2 + BG_FDN_ITEMS;
__device__ __forceinline__ void bg_issue(const Args& a, int j, LAS unsigned char* scr, int lane) {
    const float* W; int ld;
    if (j < BG_GU_ITEMS) { const int e = j / BG_PER_EXPERT, r = j - e * BG_PER_EXPERT, kb = r / 448, nb = r - kb * 448, n0 = nb * 32, p = n0 >> 8, r0 = n0 & 255;
        W = ((r0 & 128) ? a.in[I_MUP] : a.in[I_MGATE]) + (size_t)e * 2048 * FE + (size_t)(kb * 64) * FE + 128 * p + (r0 & 127); ld = FE; }
    else if (j < BG_J1) { const int jj = j - BG_GU_ITEMS, e = jj / BG_DN_PER_EXPERT, r = jj - e * BG_DN_PER_EXPERT, kb = r >> 6, nb = r & 63;
        W = a.in[I_MDOWN] + (size_t)e * FE * 2048 + (size_t)(kb * 64) * 2048 + nb * 32; ld = 2048; }
    else if (j < BG_J2) { const int r = j - BG_J1, kb = r / 352, nb = r - kb * 352, n0 = nb * 32, p = n0 >> 8, r0 = n0 & 255;
        W = ((r0 & 128) ? a.in[I_FUP] : a.in[I_FGATE]) + (size_t)(kb * 64) * FFN + 128 * p + (r0 & 127); ld = FFN; }
    else { const int r = j - BG_J2, kb = r >> 6, nb = r & 63; W = a.in[I_FDOWN] + (size_t)(kb * 64) * 2048 + nb * 32; ld = 2048; }
    const unsigned loff = (unsigned)((lane >> 3) * ld + (lane & 7) * 4) * 4u;
#pragma unroll
    for (int p8 = 0; p8 < 8; ++p8) __builtin_amdgcn_global_load_lds((const unsigned*)((const char*)(W + (size_t)(8 * p8) * ld) + loff), (LAS unsigned*)(scr + p8 * 1024), 16, 0, 0);
}
__device__ __forceinline__ void bg_flush(unsigned char* ws, int j, const LAS unsigned char* scr, int lane) {
    const int n = lane & 31, kh = lane >> 5; unsigned char* dst; float sc;
    if (j < BG_GU_ITEMS) { const int e = j / BG_PER_EXPERT, r = j - e * BG_PER_EXPERT, kb = r / 448, nb = r - kb * 448;
        dst = ws + WS_W_MGU + (size_t)e * 2 * FE * 2048 + (size_t)(nb * 32 + n) * 2048 + kb * 64 + 32 * kh; sc = 1.f / SWGU8; }
    else if (j < BG_J1) { const int jj = j - BG_GU_ITEMS, e = jj / BG_DN_PER_EXPERT, r = jj - e * BG_DN_PER_EXPERT, kb = r >> 6, nb = r & 63;
        dst = ws + WS_W_MDN + (size_t)e * 2048 * FE + (size_t)(nb * 32 + n) * FE + kb * 64 + 32 * kh; sc = 1.f / SWDN8; }
    else { const LAS float* s = (const LAS float*)scr + (32 * kh) * 32 + n;
        if (j < BG_J2) { const int r = j - BG_J1, kb = r / 352, nb = r - kb * 352; dst = ws + WS_W_GU + ((size_t)(nb * 32 + n) * 2048 + kb * 64 + 32 * kh) * 2; }
        else { const int r = j - BG_J2, kb = r >> 6, nb = r & 63; dst = ws + WS_W_DN + ((size_t)(nb * 32 + n) * FFN + kb * 64 + 32 * kh) * 2; }
#pragma unroll
        for (int h = 0; h < 4; ++h) { const f32x4 x0 = (f32x4){s[(8 * h + 0) * 32], s[(8 * h + 1) * 32], s[(8 * h + 2) * 32], s[(8 * h + 3) * 32]}, x1 = (f32x4){s[(8 * h + 4) * 32], s[(8 * h + 5) * 32], s[(8 * h + 6) * 32], s[(8 * h + 7) * 32]};
            *(u32x4*)(dst + 16 * h) = pack8(x0, x1); }
        return; }
    const LAS float* s = (const LAS float*)scr + (32 * kh) * 32 + n;
#pragma unroll
    for (int h = 0; h < 2; ++h) { u32x4 o;
        o.x = pack4_fp8_sc(s[(16 * h + 0) * 32], s[(16 * h + 1) * 32], s[(16 * h + 2) * 32], s[(16 * h + 3) * 32], sc);
        o.y = pack4_fp8_sc(s[(16 * h + 4) * 32], s[(16 * h + 5) * 32], s[(16 * h + 6) * 32], s[(16 * h + 7) * 32], sc);
        o.z = pack4_fp8_sc(s[(16 * h + 8) * 32], s[(16 * h + 9) * 32], s[(16 * h + 10) * 32], s[(16 * h + 11) * 32], sc);
        o.w = pack4_fp8_sc(s[(16 * h + 12) * 32], s[(16 * h + 13) * 32], s[(16 * h + 14) * 32], s[(16 * h + 15) * 32], sc);
        *(u32x4*)(dst + 16 * h) = o; }
}
__device__ __forceinline__ void sincos_d(double x, double& s, double& c) {
    const double kd = rint(x * 0.63661977236758134308); const double r = (x - kd * 1.57079632673412561417e+00) - kd * 6.07710050650619224932e-11; const double r2 = r * r;
    double sp = -7.6471637318198164759e-13; sp = sp * r2 + 1.6059043836821614599e-10; sp = sp * r2 - 2.5052108385441718775e-08; sp = sp * r2 + 2.7557319223985890653e-06;
    sp = sp * r2 - 1.9841269841269841270e-04; sp = sp * r2 + 8.3333333333333333333e-03; sp = sp * r2 - 1.6666666666666666667e-01; const double sr = r + r * r2 * sp;
    double cp = 4.7794773323873852974e-14; cp = cp * r2 - 1.1470745597729724714e-11; cp = cp * r2 + 2.0876756987868098979e-09; cp = cp * r2 - 2.7557319223985890653e-07;
    cp = cp * r2 + 2.4801587301587301587e-05; cp = cp * r2 - 1.3888888888888888889e-03; cp = cp * r2 + 4.1666666666666666667e-02; cp = cp * r2 - 0.5; const double cr = 1.0 + r2 * cp;
    const int q = ((int)kd) & 3;
    s = (q == 0) ? sr : (q == 1) ? cr : (q == 2) ? -sr : -cr; c = (q == 0) ? cr : (q == 1) ? -sr : (q == 2) ? -cr : sr;
}
constexpr int I0 = 32 * 68, I1 = I0 + 8 * 24, I2 = I1 + 8 * 32, I3 = I2 + 1024, I4 = I3 + 32 * 176, I5 = I4 + 88 * 32, I6 = I5 + 1024, I7 = I6 + 4 * 64, I8 = I7 + 1024,
              I9 = I8 + 8 * 32 * 224, I10 = I9 + 8 * 112 * 32;
#ifndef TAIL_ITEMS_1
#define TAIL_ITEMS_1 7992
#endif
#ifndef TAIL_ITEMS_2
#define TAIL_ITEMS_2 5000
#endif
constexpr int I_B = I10 - TAIL_ITEMS_2, I_A = I_B - TAIL_ITEMS_1;
static_assert((I_A - I9) % 64 == 0 && BG_DN_ITEMS == 2 * (I_A - I9), "the background down-weight items are exactly the prologue-form items [I9, I_A)");
__device__ __forceinline__ void convert_range(Frame& F, const Args& a, int begin, int end, int w, int nw) {
    LAS float* scr = (LAS float*)(F.lds + F.wave * 16896);
    unsigned char* ws = F.ws;
    auto decode = [&](int it, TD& d) {
        const float* W; const float* W2 = nullptr; const float* ksc = nullptr; const float* nsc = nullptr; bf16_t* WT; int K, Nsrc, Ndst, kind = TK_PLAIN, item;
        if (it < I0) { W = a.in[I_WIN]; K = 2048; Nsrc = 4168; Ndst = NIN; kind = TK_IN; WT = (bf16_t*)(ws + WS_W_IN); item = it; }
        else if (it < I1) { W = a.in[I_WUQ]; K = 512; Nsrc = 1536; Ndst = 1536; kind = TK_UQ; ksc = a.in[I_QNORM]; WT = (bf16_t*)(ws + WS_W_UP); item = it - I0; }
        else if (it < I2) { W = a.in[I_WUKV]; K = 512; Nsrc = 2048; Ndst = 2048; kind = TK_UKV; ksc = a.in[I_KVNORM]; WT = (bf16_t*)(ws + WS_W_UP) + (size_t)1536 * 512; item = it - I1; }
        else if (it < I3) { W = a.in[I_WOUT]; K = 2048; Nsrc = 2048; Ndst = 2048; WT = (bf16_t*)(ws + WS_W_OUT); item = it - I2; }
        else if (it < I4) { W = a.in[I_FGATE]; W2 = a.in[I_FUP]; K = 2048; Nsrc = FFN; Ndst = 2 * FFN; kind = TK_GU; WT = (bf16_t*)(ws + WS_W_GU); item = it - I3; }
        else if (it < I5) { W = a.in[I_FDOWN]; K = FFN; Nsrc = 2048; Ndst = 2048; WT = (bf16_t*)(ws + WS_W_DN); item = it - I4; }
        else if (it < I6) { W = a.in[I_PWIN]; K = 2048; Nsrc = 2048; Ndst = 2048; ksc = a.in[I_LNFG]; WT = (bf16_t*)(ws + WS_W_PIN); item = it - I5; }
        else if (it < I7) { const int r = it - I6, g = r >> 6; W = a.in[I_PWGRP] + (size_t)g * 512 * 512; K = 512; Nsrc = 512; Ndst = 512; nsc = a.in[I_PSCALE] + g * 512; WT = (bf16_t*)(ws + WS_W_GRP) + (size_t)g * 512 * 512; item = r & 63; }
        else if (it < I8) { W = a.in[I_PWOUT]; K = 2048; Nsrc = 2048; Ndst = 2048; WT = (bf16_t*)(ws + WS_W_POUT); item = it - I7; }
        else if (it < I9) { const int r = it - I8, e = r / (32 * 224); W = a.in[I_MGATE] + (size_t)e * 2048 * FE; W2 = a.in[I_MUP] + (size_t)e * 2048 * FE; K = 2048; Nsrc = FE; Ndst = 2 * FE; kind = TK_GU; WT = (bf16_t*)(ws + WS_W_MGU + (size_t)e * 2 * FE * 2048); item = r % (32 * 224); }
        else { const int r = it - I9, e = r / (112 * 32); W = a.in[I_MDOWN] + (size_t)e * FE * 2048; K = FE; Nsrc = 2048; Ndst = 2048; WT = (bf16_t*)(ws + WS_W_MDN + (size_t)e * 2048 * FE); item = r % (112 * 32); }
        const int f8 = it >= I8 ? 1 : 0; const int nblk = f8 ? Ndst / 32 : Ndst / 64;
        d.q8 = (it >= I3 && it < I4) ? 512.f : ((it >= I4 && it < I5) ? 2048.f : 0.f); d.fp8 = f8; d.wsc = it >= I9 ? SWDN8 : SWGU8; d.W = W; d.W2 = W2; d.ksc = ksc; d.nsc = nsc; d.WT = WT; d.K = K; d.Nsrc = Nsrc; d.kind = kind;
        d.k0 = f8 ? 128 * (item / nblk) : 64 * (item / nblk); d.n0 = f8 ? 32 * (item % nblk) : 64 * (item % nblk);
    };
    TD cur, nxt; f32x2 v[32]; int it = begin + w;
    if (it < end) { decode(it, cur); if (cur.fp8) t_load8(cur, F.lane, v); else t_load(cur, F.lane, v); }
    while (it < end) {
        if (cur.fp8) t_to_lds8(F.lane, v, scr); else t_to_lds(F.lane, v, scr);
        const int itn = it + nw;
        if (itn < end) { decode(itn, nxt); if (nxt.fp8) t_load8(nxt, F.lane, v); else t_load(nxt, F.lane, v); }
        LDS_WAIT(); asm volatile("" ::: "memory");
        if (cur.fp8) t_store8(cur, F.lane, scr); else t_store(cur, F.lane, scr);
        LDS_WAIT(); asm volatile("" ::: "memory");
        cur = nxt; it = itn;
    }
}
__device__ __forceinline__ void p0_prologue(Frame& F, const Args& a) {
    const int gw = F.vcu * 8 + F.wave, NGW = F.G * 8;
    unsigned char* ws = F.ws;
#if BG_IN_ATTN
    convert_range(F, a, 0, I3, gw, NGW);
    convert_range(F, a, I5, I8, gw, NGW);
    if (F.G != 256) convert_range(F, a, I_A, I10, gw, NGW);
#elif BG_IN_PROLOGUE
    convert_range(F, a, 0, I8, gw, NGW);
    convert_range(F, a, I9, F.G == 256 ? I_A : I10, gw, NGW);
    { LAS unsigned char* bscr = F.lds + F.wave * 16896;
      for (int j = gw; j < BG_GU_ITEMS; j += NGW) { bg_issue(a, j, bscr, F.lane); VM_WAIT(); asm volatile("" ::: "memory"); bg_flush(ws, j, bscr, F.lane); LDS_WAIT(); asm volatile("" ::: "memory"); } }
#else
    convert_range(F, a, 0, F.G == 256 ? I_A : I10, gw, NGW);
#endif
    { float* cs = (float*)(ws + WS_CS); const int gt = (F.vcu * 8 + F.wave) * 64 + F.lane, NT = F.G * 512;
      for (int i = gt; i < R * 32; i += NT) { const int row = i >> 5, j = i & 31; const int pos = row >= PADR ? row - PADR : 0;
          const float ang = (float)pos * INV_FREQ[j]; double s, c; sincos_d((double)ang, s, c); cs[(size_t)row * 64 + j] = (float)c; cs[(size_t)row * 64 + 32 + j] = (float)s; } }
    { bf16_t* hb = (bf16_t*)(ws + WS_L_H0B);
      for (int row = gw; row < R; row += NGW) { const float* src = row >= ROW0 ? a.in[I_X] + (size_t)(row - ROW0) * DM : (row >= PADR ? a.in[I_META] + (size_t)(row - PADR) * DM : nullptr);
#pragma unroll
          for (int j = 0; j < 4; ++j) { const int col = 8 * F.lane + 512 * j; f32x4 v0 = (f32x4){0.f, 0.f, 0.f, 0.f}, v1 = v0; if (src) { v0 = *(const f32x4*)(src + col); v1 = *(const f32x4*)(src + col + 4); }
              *(u32x4*)(hb + (size_t)row * DM + col) = pack8(v0, v1); } } }
}

__device__ __forceinline__ void p2_ext(Frame& F) {
    unsigned char* ws = F.ws; const float* lf = (const float*)(ws + WS_L_LF); const float* kr = (const float*)(ws + WS_L_KR); const float* cs = (const float*)(ws + WS_CS);
    bf16_t* qp = (bf16_t*)(ws + WS_L_QP); bf16_t* kp = (bf16_t*)(ws + WS_L_KP);
    LAS double* red = (LAS double*)(F.lds);
    const int CH = (LTOK + F.G - 1) / F.G;
    for (int ch = blockIdx.x; ch * CH < LTOK; ch += F.G) {
        const int p0 = ch * CH, p1 = (p0 + CH < LTOK) ? p0 + CH : LTOK;
        double accd[8];
#pragma unroll
        for (int h = 0; h < 8; ++h) accd[h] = 0.0;
        for (int p = F.tid; p < p0; p += 512) { const f32x4 a0 = *(const f32x4*)(lf + (size_t)(PADR + p) * 8), a1 = *(const f32x4*)(lf + (size_t)(PADR + p) * 8 + 4);
#pragma unroll
            for (int h = 0; h < 4; ++h) { accd[h] += (double)a0[h]; accd[4 + h] += (double)a1[h]; } }
#pragma unroll
        for (int h = 0; h < 8; ++h) { const double s = wave_sum_d(accd[h]); if (F.lane == 0) red[F.wave * 8 + h] = s; }
        __syncthreads();
        if (F.tid < 8) { double s = 0.0; for (int w = 0; w < 8; ++w) s += red[w * 8 + F.tid]; red[64 + F.tid] = s; }
        __syncthreads();
        const int nrow = p1 - p0;
        if (F.tid < nrow * 8) { const int r = F.tid >> 3, h = F.tid & 7; double c = red[64 + h];
            for (int i = 0; i <= r; ++i) c += (double)lf[(size_t)(PADR + p0 + i) * 8 + h];
            const float cf = (float)(c * 1.4426950408889634074);
            const float hi = bf2f(f2bf(cf)), r1 = cf - hi, mid = bf2f(f2bf(r1)), r2 = r1 - mid, lo = bf2f(f2bf(r2));
            const int pos = p0 + r, row = PADR + pos;
            u32x4 z = (u32x4){0u, 0u, 0u, 0u};
            u32x4 q0; q0.x = cvt_pk_bf16(hi, mid); q0.y = cvt_pk_bf16(lo, 1.f); q0.z = cvt_pk_bf16(1.f, 1.f); q0.w = 0u;
            u32x4 k0 = z; if (pos >= NMETA) { k0.x = cvt_pk_bf16(1.f, 1.f); k0.y = cvt_pk_bf16(1.f, -hi); k0.z = cvt_pk_bf16(-mid, -lo); }
            u32x4* qd = (u32x4*)(qp + ((size_t)(8 + h) * R + row) * DKP + 128); u32x4* kd = (u32x4*)(kp + ((size_t)(8 + h) * R + row) * DKP + 128);
            qd[0] = q0; kd[0] = k0;
#pragma unroll
            for (int j = 1; j < 8; ++j) { qd[j] = z; kd[j] = z; }
        }
        for (int i = F.tid; i < nrow * 32; i += 512) { const int r = i >> 5, j = i & 31, row = PADR + p0 + r;
            const float x1 = kr[(size_t)row * 64 + j], x2 = kr[(size_t)row * 64 + 32 + j], c = cs[(size_t)row * 64 + j], s = cs[(size_t)row * 64 + 32 + j];
            const bf16_t o1 = f2bf(x1 * c - x2 * s), o2 = f2bf(x2 * c + x1 * s);
#pragma unroll
            for (int h = 0; h < 8; ++h) { bf16_t* k = kp + ((size_t)h * R + row) * DKP + 128; k[j] = o1; k[32 + j] = o2; } }
        __syncthreads();
    }
}

__device__ __forceinline__ void p3_attn_naive(Frame& F) {
    unsigned char* ws = F.ws; const bf16_t* QP = (const bf16_t*)(ws + WS_L_QP); const bf16_t* KP = (const bf16_t*)(ws + WS_L_KP); const bf16_t* VP = (const bf16_t*)(ws + WS_L_VP);
    bf16_t* O = (bf16_t*)(ws + WS_L_O);
    LAS float* qs = (LAS float*)(F.lds + F.wave * 1024);
    const int gw = F.vcu * 8 + F.wave, NGW = F.G * 8, lane = F.lane;
    for (int t = gw; t < NH * LTOK; t += NGW) {
        const int head = t / LTOK, pos = t % LTOK, row = pos + PADR;
        const bf16_t* q = QP + ((size_t)head * R + row) * DKP;
        LDS_WAIT();
        for (int d = lane; d < DKP; d += 64) qs[d] = bf2f(q[d]);
        LDS_WAIT(); asm volatile("" ::: "memory");
        float mrun = -1e30f, l = 0.f, o0 = 0.f, o1 = 0.f; const int nk = pos + 1;
        for (int k0 = 0; k0 < nk; k0 += 64) {
            const int kpos = k0 + lane; float s = -__builtin_inff();
            if (kpos < nk) { const u32x4* kr = (const u32x4*)(KP + ((size_t)head * R + PADR + kpos) * DKP); float a = 0.f;
#pragma unroll 4
                for (int c = 0; c < 24; ++c) { const u32x4 kv = kr[c];
                    a += qs[c * 8 + 0] * bf_lo(kv.x) + qs[c * 8 + 1] * bf_hi(kv.x) + qs[c * 8 + 2] * bf_lo(kv.y) + qs[c * 8 + 3] * bf_hi(kv.y)
                       + qs[c * 8 + 4] * bf_lo(kv.z) + qs[c * 8 + 5] * bf_hi(kv.z) + qs[c * 8 + 6] * bf_lo(kv.w) + qs[c * 8 + 7] * bf_hi(kv.w); }
                s = a; }
            const float mn = fmaxf(mrun, wave_max(s)); const float alpha = __builtin_amdgcn_exp2f(mrun - mn); const float p = __builtin_amdgcn_exp2f(s - mn);
            l = l * alpha + wave_sum(p); o0 *= alpha; o1 *= alpha; mrun = mn;
            const int kn = (nk - k0) < 64 ? (nk - k0) : 64;
            for (int j = 0; j < kn; ++j) { const float pj = __shfl(p, j); const unsigned vv = *(const unsigned*)(VP + ((size_t)head * R + PADR + k0 + j) * DV + 2 * lane);
                o0 += pj * bf_lo(vv); o1 += pj * bf_hi(vv); }
        }
        const float il = 1.0f / l;
        *(unsigned*)(O + (size_t)row * DM + head * DV + 2 * lane) = cvt_pk_bf16(o0 * il, o1 * il);
    }
}


namespace att {
typedef float f32x16 __attribute__((ext_vector_type(16)));
typedef short s16x4 __attribute__((ext_vector_type(4)));
typedef LAS char* lptr; typedef const LAS char* lcptr;
constexpr int KVBLK = 64, KROW = 400, SHM_K = KVBLK * KROW, SHM_V = KVBLK * DV * 2;
constexpr int OFF_V = 0, OFF_K = 2 * SHM_V, OFF_WS = OFF_K + 2 * SHM_K, LDS_NEED = OFF_WS + 8 * 64 * 4;
constexpr float THR2 = 11.5f;
#define AT_KSWZ(row, colB) ((row) * KROW + (colB))
#define AT_SBAR() __builtin_amdgcn_sched_barrier(0)
__device__ __forceinline__ int v_st(int k, int c) { const int kk = (k & ~0xC) | ((k & 4) << 1) | ((k & 8) >> 1); return ((kk >> 3) * 4 + (c >> 5)) * 512 + ((kk & 7) * 32 + (c & 31)) * 2; }
__device__ __forceinline__ int v_rd_base(int lane) { return ((lane & 3) << 3) | (((lane >> 2) & 3) << 6) | (((lane >> 4) & 1) << 5) | (((lane >> 5) & 1) << 8); }
constexpr int v_rd_off(int d0, int ks, int half) { return d0 * 512 + ks * 4096 + half * 2048; }
__device__ __forceinline__ int crow(int r, int hi) { return (r & 3) + 8 * (r >> 2) + 4 * hi; }
__device__ __forceinline__ void mask_causal(f32x16& p0, f32x16& p1, int dq) {
    const float NEG = -__builtin_inff();
#pragma unroll
    for (int r = 0; r < 16; ++r) { const int c = (r & 3) + 8 * (r >> 2); if (dq - c < 0) p0[r] = NEG; if (dq - c - 32 < 0) p1[r] = NEG; }
}
__device__ __forceinline__ void mask_pad(f32x16& p0, f32x16& p1) {
    const float NEG = -__builtin_inff();
#pragma unroll
    for (int r = 0; r < 16; ++r) { p0[r] = NEG; if (r < 8) p1[r] = NEG; }
}
__device__ __forceinline__ void partialSM(f32x16& p0, f32x16& p1, float& m_reg, float& mn, float& alpha) {
    float pmax = p0[0];
#pragma unroll
    for (int r = 1; r < 16; ++r) pmax = fmaxf(pmax, p0[r]);
#pragma unroll
    for (int r = 0; r < 16; ++r) pmax = fmaxf(pmax, p1[r]);
    { auto rr = __builtin_amdgcn_permlane32_swap(__float_as_uint(pmax), __float_as_uint(pmax), false, false);
      pmax = fmaxf(__uint_as_float(rr[0]), __uint_as_float(rr[1])); }
    if (__builtin_expect(__all((pmax - m_reg) <= THR2), 1)) { mn = m_reg; alpha = 1.f; }
    else { mn = fmaxf(m_reg, pmax); alpha = __builtin_amdgcn_exp2f(m_reg - mn); m_reg = mn; }
#pragma unroll
    for (int r = 0; r < 16; ++r) p0[r] = __builtin_amdgcn_exp2f(p0[r] - mn);
}
__device__ __forceinline__ void finishSM(f32x16& p0, f32x16& p1, float mn, float alpha, float& l_reg, bf16x8& pa0, bf16x8& pa1, bf16x8& pa2, bf16x8& pa3) {
#pragma unroll
    for (int r = 0; r < 16; ++r) p1[r] = __builtin_amdgcn_exp2f(p1[r] - mn);
    float ps = 0;
#pragma unroll
    for (int r = 0; r < 16; ++r) ps += p0[r];
#pragma unroll
    for (int r = 0; r < 16; ++r) ps += p1[r];
    { auto rr = __builtin_amdgcn_permlane32_swap(__float_as_uint(ps), __float_as_uint(ps), false, false);
      ps = __uint_as_float(rr[0]) + __uint_as_float(rr[1]); }
    l_reg = l_reg * alpha + ps;
#define AT_PK4(P, B_, OUT) do { unsigned a0 = cvt_pk_bf16(P[B_+0], P[B_+1]), a1 = cvt_pk_bf16(P[B_+2], P[B_+3]);                          \
        unsigned b0 = cvt_pk_bf16(P[B_+4], P[B_+5]), b1 = cvt_pk_bf16(P[B_+6], P[B_+7]);                                             \
        auto r0 = __builtin_amdgcn_permlane32_swap(a0, b0, false, false); auto r1 = __builtin_amdgcn_permlane32_swap(a1, b1, false, false); \
        u32x4 w = {r0[0], r1[0], r0[1], r1[1]}; OUT = __builtin_bit_cast(bf16x8, w); } while (0)
    AT_PK4(p0, 0, pa0); AT_PK4(p0, 8, pa1); AT_PK4(p1, 0, pa2); AT_PK4(p1, 8, pa3);
#undef AT_PK4
}
#define AT_LGK(n) asm volatile("s_waitcnt lgkmcnt(" #n ")" ::: "memory")
__device__ __forceinline__ void qkt(f32x16& p0, f32x16& p1, lcptr kbuf, int r32, int hi, const bf16x8* qr) {
    p0 = f32x16{}; p1 = f32x16{};
    const unsigned kb = (unsigned)(size_t)kbuf + (unsigned)AT_KSWZ(r32, hi * 16);
    bf16x8 fa0, fa1, fb0, fb1, fc0, fc1;
#define QK_RD(dst, off) asm volatile("ds_read_b128 %0, %1 offset:%2" : "=&v"(dst) : "v"(kb), "i"(off) : "memory")
#define QK_LD(X, d0) do { QK_RD(X##0, 32 * (d0)); QK_RD(X##1, 32 * (d0) + 32 * KROW); } while (0)
#define QK_MM(X, d0) do { p0 = __builtin_amdgcn_mfma_f32_32x32x16_bf16(X##0, qr[d0], p0, 0, 0, 0); p1 = __builtin_amdgcn_mfma_f32_32x32x16_bf16(X##1, qr[d0], p1, 0, 0, 0); } while (0)
    QK_LD(fa, 0); QK_LD(fb, 1);
    QK_LD(fc, 2); AT_LGK(4); AT_SBAR(); QK_MM(fa, 0); AT_SBAR();
    QK_LD(fa, 3); AT_LGK(4); AT_SBAR(); QK_MM(fb, 1); AT_SBAR();
    QK_LD(fb, 4); AT_LGK(4); AT_SBAR(); QK_MM(fc, 2); AT_SBAR();
    QK_LD(fc, 5); AT_LGK(4); AT_SBAR(); QK_MM(fa, 3); AT_SBAR();
    QK_LD(fa, 6); AT_LGK(4); AT_SBAR(); QK_MM(fb, 4); AT_SBAR();
    QK_LD(fb, 7); AT_LGK(4); AT_SBAR(); QK_MM(fc, 5); AT_SBAR();
    QK_LD(fc, 8); AT_LGK(4); AT_SBAR(); QK_MM(fa, 6); AT_SBAR();
    QK_LD(fa, 9); AT_LGK(4); AT_SBAR(); QK_MM(fb, 7); AT_SBAR();
    QK_LD(fb, 10); AT_LGK(4); AT_SBAR(); QK_MM(fc, 8); AT_SBAR();
    QK_LD(fc, 11); AT_LGK(4); AT_SBAR(); QK_MM(fa, 9); AT_SBAR();
    AT_LGK(2); AT_SBAR(); QK_MM(fb, 10); AT_SBAR();
    AT_LGK(0); AT_SBAR(); QK_MM(fc, 11);
#undef QK_RD
#undef QK_LD
#undef QK_MM
}
template <int VB>
__device__ __forceinline__ void pv_tile(f32x16* o, unsigned vb0, bf16x8 pa0, bf16x8 pa1, bf16x8 pa2, bf16x8 pa3) {
    s16x4 al0, ah0, al1, ah1, al2, ah2, al3, ah3, bl0, bh0, bl1, bh1, bl2, bh2, bl3, bh3;
#define AT_TRRD(dst, off) asm volatile("ds_read_b64_tr_b16 %0, %1 offset:%2" : "=&v"(dst) : "v"(vb0), "i"(off) : "memory")
#define PV_RDA(S, d0) do { constexpr int b_ = VB * SHM_V + v_rd_off(d0, 0, 0); AT_TRRD(S##l0, b_); AT_TRRD(S##h0, b_ + 2048); AT_TRRD(S##l1, b_ + 4096); AT_TRRD(S##h1, b_ + 6144); } while (0)
#define PV_RDB(S, d0) do { constexpr int b_ = VB * SHM_V + v_rd_off(d0, 0, 0); AT_TRRD(S##l2, b_ + 8192); AT_TRRD(S##h2, b_ + 10240); AT_TRRD(S##l3, b_ + 12288); AT_TRRD(S##h3, b_ + 14336); } while (0)
#define PV_MM(d0, pa, L, H) do { AT_SBAR(); o[d0] = __builtin_amdgcn_mfma_f32_32x32x16_bf16(pa, (bf16x8){L[0], L[1], L[2], L[3], H[0], H[1], H[2], H[3]}, o[d0], 0, 0, 0); AT_SBAR(); } while (0)
    PV_RDA(a, 0); PV_RDB(a, 0);
    PV_RDA(b, 1); AT_LGK(10); PV_MM(0, pa0, al0, ah0); AT_LGK(8); PV_MM(0, pa1, al1, ah1);
    PV_RDB(b, 1); AT_LGK(10); PV_MM(0, pa2, al2, ah2); AT_LGK(8); PV_MM(0, pa3, al3, ah3);
    PV_RDA(a, 2); AT_LGK(10); PV_MM(1, pa0, bl0, bh0); AT_LGK(8); PV_MM(1, pa1, bl1, bh1);
    PV_RDB(a, 2); AT_LGK(10); PV_MM(1, pa2, bl2, bh2); AT_LGK(8); PV_MM(1, pa3, bl3, bh3);
    PV_RDA(b, 3); AT_LGK(10); PV_MM(2, pa0, al0, ah0); AT_LGK(8); PV_MM(2, pa1, al1, ah1);
    PV_RDB(b, 3); AT_LGK(10); PV_MM(2, pa2, al2, ah2); AT_LGK(8); PV_MM(2, pa3, al3, ah3);
    AT_LGK(6); PV_MM(3, pa0, bl0, bh0); AT_LGK(4); PV_MM(3, pa1, bl1, bh1); AT_LGK(2); PV_MM(3, pa2, bl2, bh2); AT_LGK(0); PV_MM(3, pa3, bl3, bh3);
#undef PV_RDA
#undef PV_RDB
#undef PV_MM
#undef AT_TRRD
}
__device__ __forceinline__ void attn_block(const bf16_t* Qh, const bf16_t* Kh, const bf16_t* Vh, bf16_t* Oh, int b, bool rev, lptr lds, const Args& bga, unsigned char* bgws, int& bgt, int& bgk, int& bgp, int bgw, int bgn) {
    const int tid = threadIdx.x, wid = __builtin_amdgcn_readfirstlane(tid >> 6), lane = tid & 63, r32 = lane & 31, hi = lane >> 5;
    const int j_lo = 3, NT = 4 * b + 1;
    lptr V_lds = lds + OFF_V; lptr K_lds = lds + OFF_K;
    LAS float* wsf = (LAS float*)(lds + OFF_WS) + wid * 64; LAS float* li_l = wsf; LAS float* al_l = wsf + 32;
    LAS unsigned char* bscr = (LAS unsigned char*)(lds + LDS_NEED) + wid * 8192;
    const int qlo = 256 * b + wid * 32, qrow = qlo + r32;
    unsigned koff[3], voff[2];
#pragma unroll
    for (int i = 0; i < 3; ++i) { const int g = (wid + 8 * i) * 64 + lane, row = g / 25, cp = g - row * 25; koff[i] = (unsigned)(row * 384 + (cp < 24 ? cp : 0) * 16); }
    unsigned koff3; { const int g = 24 * 64 + lane, row = g / 25, cp = g - row * 25; koff3 = (unsigned)(row * 384 + (cp < 24 ? cp : 0) * 16); }
#pragma unroll
    for (int i = 0; i < 2; ++i) { const int byte = ((wid + 8 * i) * 64 + lane) * 16, sub = byte >> 9, el = (byte & 511) >> 1, kk = (sub >> 2) * 8 + (el >> 5), c = (sub & 3) * 32 + (el & 31);
        const int k = (kk & ~0xC) | ((kk & 4) << 1) | ((kk & 8) >> 1); voff[i] = (unsigned)(k * 256 + c * 2); }
    const unsigned vb0 = (unsigned)(size_t)V_lds + (unsigned)v_rd_base(lane);
    bf16x8 qr[12];
#pragma unroll
    for (int d0 = 0; d0 < 12; ++d0) qr[d0] = *(const bf16x8*)(Qh + (size_t)qrow * DKP + d0 * 16 + hi * 8);
#define AT_JJ(t) (rev ? j_lo + NT - 1 - (t) : j_lo + (t))
#define AT_SLOAD(t, bf) do { const char* kt = (const char*)(Kh + (size_t)AT_JJ(t) * KVBLK * DKP); const char* vt = (const char*)(Vh + (size_t)AT_JJ(t) * KVBLK * DV); \
        _Pragma("unroll") for (int i_ = 0; i_ < 3; ++i_) __builtin_amdgcn_global_load_lds((const unsigned*)(kt + koff[i_]), (LAS unsigned*)(K_lds + (bf) * SHM_K + (wid + 8 * i_) * 1024), 16, 0, 0); \
        if (wid == 0) __builtin_amdgcn_global_load_lds((const unsigned*)(kt + koff3), (LAS unsigned*)(K_lds + (bf) * SHM_K + 24 * 1024), 16, 0, 0); \
        _Pragma("unroll") for (int i_ = 0; i_ < 2; ++i_) __builtin_amdgcn_global_load_lds((const unsigned*)(vt + voff[i_]), (LAS unsigned*)(V_lds + (bf) * SHM_V + (wid + 8 * i_) * 1024), 16, 0, 0); } while (0)
    AT_SLOAD(0, 0); VM_WAIT();
    __syncthreads();
    float m_reg = -1e30f, l_reg = 0.f; f32x16 o[4] = {};
    f32x16 p0, p1; float mn, alpha; bf16x8 pa0, pa1, pa2, pa3;
#define AT_TILE(t, BUF) do { \
        if ((t) + 1 < NT) AT_SLOAD((t) + 1, (BUF) ^ 1); \
        AT_SBAR(); qkt(p0, p1, K_lds + (BUF) * SHM_K, r32, hi, qr); AT_SBAR(); \
        bool bgi_ = false; \
        if (BG_IN_ATTN) { if (bgp >= 0) { if ((t) + 1 < NT) asm volatile("s_waitcnt vmcnt(5)" ::: "memory"); else VM_WAIT(); bg_flush(bgws, bgp, bscr, lane); bgp = -1; LDS_WAIT(); } \
            if ((unsigned)(bgt + wid) % 3u < 2u) { const int bj_ = bgk * bgn + bgw; if (bj_ < BG_ITEMS) { bg_issue(bga, bj_, bscr, lane); bgp = bj_; ++bgk; bgi_ = true; } } ++bgt; } AT_SBAR(); \
        { const int jj_ = AT_JJ(t), kb_ = jj_ * KVBLK; if (jj_ == j_lo) mask_pad(p0, p1); if (kb_ + KVBLK - 1 > qlo) mask_causal(p0, p1, qrow - kb_ - 4 * hi); } \
        partialSM(p0, p1, m_reg, mn, alpha); \
        if (__any(alpha < 1.f)) { if (hi == 0) al_l[r32] = alpha; LDS_WAIT(); \
            _Pragma("unroll") for (int d_ = 0; d_ < 4; ++d_) _Pragma("unroll") for (int r = 0; r < 16; ++r) o[d_][r] *= al_l[crow(r, hi)]; } \
        finishSM(p0, p1, mn, alpha, l_reg, pa0, pa1, pa2, pa3); AT_SBAR(); \
        pv_tile<BUF>(o, vb0, pa0, pa1, pa2, pa3); \
        if (bgi_) asm volatile("s_waitcnt vmcnt(8)" ::: "memory"); else VM_WAIT(); LDS_WAIT(); __builtin_amdgcn_s_barrier(); } while (0)
    for (int t = 0; t < NT; t += 2) { AT_TILE(t, 0); if (t + 1 < NT) AT_TILE(t + 1, 1); }
    if (hi == 0) li_l[r32] = l_reg; LDS_WAIT();
    float rli[16];
#pragma unroll
    for (int r = 0; r < 16; ++r) { const float lv = li_l[crow(r, hi)]; rli[r] = lv > 0.f ? __builtin_amdgcn_rcpf(lv) : 0.f; }
    bf16_t* Ow = Oh + (size_t)qlo * DM;
#pragma unroll
    for (int r = 0; r < 16; ++r) { const int orow = crow(r, hi);
#pragma unroll
        for (int d0 = 0; d0 < 4; ++d0) { const float v = o[d0][r] * rli[r]; const float vn = __shfl_xor(v, 1);
            if ((r32 & 1) == 0) *(unsigned*)(Ow + (size_t)orow * DM + d0 * 32 + r32) = cvt_pk_bf16(v, vn); } }
    __syncthreads();
#undef AT_SLOAD
#undef AT_JJ
#undef AT_TILE
}
}
__device__ __forceinline__ void p3_attn(Frame& F, const Args& a) {
    unsigned char* ws = F.ws; const bf16_t* QP = (const bf16_t*)(ws + WS_L_QP); const bf16_t* KP = (const bf16_t*)(ws + WS_L_KP); const bf16_t* VP = (const bf16_t*)(ws + WS_L_VP);
    bf16_t* O = (bf16_t*)(ws + WS_L_O);
    att::lptr lds = (att::lptr)F.lds;
    int bgt = 0, bgk = 0, bgp = -1; const int bgw = F.vcu * 8 + F.wave, bgn = F.G * 8;
    for (int L = F.vcu; L < NH * 16; L += F.G) {
        const int nseq = L < NH ? 3 : 2;
        for (int sq = 0; sq < nseq; ++sq) {
            const int head = sq < 2 ? (L >> 4) : L, x = L & 15, b = sq == 0 ? 32 - x : (sq == 1 ? x + 1 : 0);
            att::attn_block(QP + (size_t)head * R * DKP, KP + (size_t)head * R * DKP, VP + (size_t)head * R * DV, O + head * DV, b, sq == 1, lds, a, ws, bgt, bgk, bgp, bgw, bgn);
        }
    }
    if (BG_IN_ATTN) {
        LAS unsigned char* bscr = (LAS unsigned char*)(F.lds + att::LDS_NEED) + F.wave * 8192;
        VM_WAIT(); asm volatile("" ::: "memory");
        if (bgp >= 0) { bg_flush(ws, bgp, bscr, F.lane); LDS_WAIT(); asm volatile("" ::: "memory"); }
        for (int j = bgk * bgn + bgw; j < BG_ITEMS; j += bgn) { bg_issue(a, j, bscr, F.lane); VM_WAIT(); asm volatile("" ::: "memory"); bg_flush(ws, j, bscr, F.lane); LDS_WAIT(); asm volatile("" ::: "memory"); }
    }
}

__device__ __forceinline__ void ln_core(f32x4 (&v)[8], const float* g, const float* b, int lane, float* mean_out = nullptr, float* rstd_out = nullptr) {
    float s = 0.f;
#pragma unroll
    for (int j = 0; j < 8; ++j) s += (v[j][0] + v[j][1]) + (v[j][2] + v[j][3]);
    const float mean = wave_sum(s) * (1.f / DM); float s2 = 0.f;
#pragma unroll
    for (int j = 0; j < 8; ++j) { v[j] = v[j] - mean; s2 += (v[j][0] * v[j][0] + v[j][1] * v[j][1]) + (v[j][2] * v[j][2] + v[j][3] * v[j][3]); }
    const float rstd = 1.f / sqrtf(wave_sum(s2) * (1.f / DM) + LN_EPS);
    if (mean_out) { *mean_out = mean; *rstd_out = rstd; }
#pragma unroll
    for (int j = 0; j < 8; ++j) { const f32x4 gg = *(const f32x4*)(g + 4 * lane + 256 * j), bb = *(const f32x4*)(b + 4 * lane + 256 * j); v[j] = v[j] * rstd * gg + bb; }
}
__device__ __forceinline__ void ln_phase(Frame& F, const float* Y, const float* g, const float* b, float* stats, bf16_t* HB, bool emu = false) {
    const int gw = F.vcu * 8 + F.wave, NGW = F.G * 8;
    f32x4 v[8], vn[8]; int row = PADR + gw;
    if (row < R) {
#pragma unroll
        for (int j = 0; j < 8; ++j) v[j] = *(const f32x4*)(Y + (size_t)row * DM + 4 * F.lane + 256 * j); }
    for (; row < R; row += NGW) {
        const int rn = row + NGW;
        if (rn < R) {
#pragma unroll
            for (int j = 0; j < 8; ++j) vn[j] = *(const f32x4*)(Y + (size_t)rn * DM + 4 * F.lane + 256 * j); }
        float mean, rstd; ln_core(v, g, b, F.lane, &mean, &rstd);
        if (F.lane == 0) *(f32x2*)(stats + (size_t)row * 2) = (f32x2){mean, rstd};
#pragma unroll
        for (int j = 0; j < 8; ++j) *(u32x2*)(HB + (size_t)row * DM + 4 * F.lane + 256 * j) = pack4((FP8_EMU && emu) ? q8v(v[j], 16.f) : v[j]);
#pragma unroll
        for (int j = 0; j < 8; ++j) v[j] = vn[j];
    }
}

template <int MODE>
__device__ __forceinline__ void skinny_meta(Frame& F, const bf16_t* A, int lda, const bf16_t* Bt, int K, float* out, const float* res, const float* g = nullptr, const float* b = nullptr) {
    LAS float* red = (LAS float*)F.lds;
    const int lane = F.lane, i16 = lane & 15, kq = lane >> 4, kc = K / 8;
    for (int ng = F.vcu; ng < DM / 16; ng += F.G) {
        const bf16_t* ap = A + (size_t)(PADR + i16) * lda + F.wave * kc + 8 * kq; const bf16_t* bp = Bt + (size_t)(ng * 16 + i16) * K + F.wave * kc + 8 * kq;
        f32x4 acc = (f32x4){0.f, 0.f, 0.f, 0.f};
#pragma unroll 8
        for (int k0 = 0; k0 < kc; k0 += 32) acc = __builtin_amdgcn_mfma_f32_16x16x32_bf16(*(const bf16x8*)(ap + k0), *(const bf16x8*)(bp + k0), acc, 0, 0, 0);
        *(LAS f32x4*)(red + (F.wave * 64 + lane) * 4) = acc;
        __syncthreads();
        if (F.tid < 256) { const int e = F.tid & 63, r = F.tid >> 6; float sum = 0.f;
#pragma unroll
            for (int w = 0; w < 8; ++w) sum += red[(w * 64 + e) * 4 + r];
            const int row = PADR + 4 * (e >> 4) + r, col = ng * 16 + (e & 15);
            if (MODE == 0) sum += ALPHA * res[(size_t)(row - PADR) * DM + col]; else if (MODE == 1) { const float mean = res[(size_t)row * 2], rstd = res[(size_t)row * 2 + 1]; sum += ALPHA * ((out[(size_t)row * DM + col] - mean) * rstd * g[col] + b[col]); }
            if (MODE == 2) ((bf16_t*)out)[(size_t)row * DM + col] = f2bf(sum); else out[(size_t)row * DM + col] = sum; }
        __syncthreads();
    }
}


__device__ __forceinline__ void calc_c12(Frame& F, const bf16_t* WT, int N, const float* g, const float* b, float* c1, float* c2, int gw, int NGW) {
    const int lane = F.lane;
    for (int n = gw; n < N; n += NGW) { float s1 = 0.f, s2 = 0.f;
#pragma unroll
        for (int j = 0; j < 4; ++j) { const int k = 8 * lane + 512 * j; const u32x4 w = *(const u32x4*)(WT + (size_t)n * DM + k);
            const f32x4 g0 = *(const f32x4*)(g + k), g1 = *(const f32x4*)(g + k + 4), b0 = *(const f32x4*)(b + k), b1 = *(const f32x4*)(b + k + 4);
            const f32x4 w0 = (f32x4){bf_lo(w.x), bf_hi(w.x), bf_lo(w.y), bf_hi(w.y)}, w1 = (f32x4){bf_lo(w.z), bf_hi(w.z), bf_lo(w.w), bf_hi(w.w)};
            const f32x4 q0 = w0 * b0 / g0, q1 = w1 * b1 / g1;
            s1 += ((w0[0] + w0[1]) + (w0[2] + w0[3])) + ((w1[0] + w1[1]) + (w1[2] + w1[3])); s2 += ((q0[0] + q0[1]) + (q0[2] + q0[3])) + ((q1[0] + q1[1]) + (q1[2] + q1[3])); }
        s1 = wave_sum(s1); s2 = wave_sum(s2);
        if (lane == 0) { c1[n] = s1; c2[n] = s2; } }
}
__device__ __forceinline__ void meta_stats(Frame& F, const float* Y, volatile LAS float* ms) {
    for (int i = F.wave; i < 16; i += 8) { f32x4 v[8]; float s = 0.f;
#pragma unroll
        for (int j = 0; j < 8; ++j) { v[j] = *(const f32x4*)(Y + (size_t)(PADR + i) * DM + 4 * F.lane + 256 * j); s += (v[j][0] + v[j][1]) + (v[j][2] + v[j][3]); }
        const float mean = wave_sum(s) * (1.f / DM); float s2 = 0.f;
#pragma unroll
        for (int j = 0; j < 8; ++j) { const f32x4 d = v[j] - mean; s2 += (d[0] * d[0] + d[1] * d[1]) + (d[2] * d[2] + d[3] * d[3]); }
        const float rstd = 1.f / sqrtf(wave_sum(s2) * (1.f / DM) + LN_EPS);
        if (F.lane == 0) { ms[2 * i] = mean; ms[2 * i + 1] = rstd; } }
    __syncthreads();
}
__device__ __forceinline__ void skinny_meta_ln(Frame& F, const float* Y, const volatile LAS float* ms, const bf16_t* Bt, const float* c2, bf16_t* out) {
    LAS float* red = (LAS float*)F.lds;
    const int lane = F.lane, i16 = lane & 15, kq = lane >> 4, kc = DM / 8; const float mean = ms[2 * i16], rstd = ms[2 * i16 + 1];
    for (int ng = F.vcu; ng < DM / 16; ng += F.G) {
        const float* ap = Y + (size_t)(PADR + i16) * DM + F.wave * kc + 8 * kq; const bf16_t* bp = Bt + (size_t)(ng * 16 + i16) * DM + F.wave * kc + 8 * kq;
        f32x4 acc = (f32x4){0.f, 0.f, 0.f, 0.f};
#pragma unroll 8
        for (int k0 = 0; k0 < kc; k0 += 32) { const f32x4 a0 = (*(const f32x4*)(ap + k0) - mean) * rstd, a1 = (*(const f32x4*)(ap + k0 + 4) - mean) * rstd;
            acc = __builtin_amdgcn_mfma_f32_16x16x32_bf16(__builtin_bit_cast(bf16x8, pack8(a0, a1)), *(const bf16x8*)(bp + k0), acc, 0, 0, 0); }
        *(LAS f32x4*)(red + (F.wave * 64 + lane) * 4) = acc;
        __syncthreads();
        if (F.tid < 256) { const int e = F.tid & 63, r = F.tid >> 6; float sum = 0.f;
#pragma unroll
            for (int w = 0; w < 8; ++w) sum += red[(w * 64 + e) * 4 + r];
            const int row = PADR + 4 * (e >> 4) + r, col = ng * 16 + (e & 15);
            out[(size_t)row * DM + col] = f2bf(sum + c2[col]); }
        __syncthreads();
    }
}

__device__ __forceinline__ f32x4 ld4bf(const bf16_t* p) { const u32x2 w = *(const u32x2*)p; return (f32x4){bf_lo(w.x), bf_hi(w.x), bf_lo(w.y), bf_hi(w.y)}; }
template <int W> __device__ __forceinline__ void pool_run(const bf16_t* HP, bf16_t* PB, int row0, int t) {
    f32x4 x[32], h[W - 1];
#pragma unroll
    for (int i = 0; i < W - 1; ++i) h[i] = ld4bf(HP + (size_t)(row0 - (W - 1) + i) * DM + 4 * t);
#pragma unroll
    for (int rr = 0; rr < 32; ++rr) x[rr] = ld4bf(HP + (size_t)(row0 + rr) * DM + 4 * t);
    f32x4 s = (f32x4){0.f, 0.f, 0.f, 0.f};
#pragma unroll
    for (int i = 0; i < W - 1; ++i) s += h[i];
    constexpr float iw = 1.0f / (float)W;
#pragma unroll
    for (int rr = 0; rr < 32; ++rr) { s += x[rr]; *(u32x2*)(PB + (size_t)(row0 + rr) * DM + 4 * t) = pack4(s * iw - x[rr]);
        const int old = rr - (W - 1); s -= old >= 0 ? x[old >= 0 ? old : 0] : h[old >= 0 ? 0 : old + (W - 1)]; }
}
__device__ __forceinline__ void p10_pool(Frame& F) {
    const bf16_t* HP = (const bf16_t*)(F.ws + WS_L_HP); bf16_t* PB = (bf16_t*)(F.ws + WS_L_PB);
    const int t = F.tid, g = F.wave >> 1;
    for (int run = blockIdx.x; run < SEQ / 32; run += F.G) { const int row0 = ROW0 + 32 * run;
        if (g == 0) pool_run<2>(HP, PB, row0, t); else if (g == 1) pool_run<4>(HP, PB, row0, t); else if (g == 2) pool_run<8>(HP, PB, row0, t); else pool_run<16>(HP, PB, row0, t); }
}

__device__ __forceinline__ void p13_ln_route(Frame& F, const Args& a) {
    unsigned char* ws = F.ws; const float* Y = (const float*)(ws + WS_Y); unsigned char* XG = ws + WS_M_XG;
    int* rinfo = (int*)(ws + WS_RINFO); float* tokg = (float*)(ws + WS_TOKG); int* tokep = (int*)(ws + WS_TOKG + 65536);
    LAS float* wr_l = (LAS float*)F.lds;
    for (int i = F.tid; i < DM * 8 / 4; i += 512) { const int c = i >> 1; *(LAS f32x4*)(wr_l + c * 8 + (c >> 2) * 4 + (i & 1) * 4) = ((const f32x4*)a.in[I_MROUTER])[i]; }
    __syncthreads();
    const float* g = a.in[I_LNMG] + DM; const float* b = a.in[I_LNMB] + DM;
    const int gw = F.vcu * 8 + F.wave, NGW = F.G * 8, lane = F.lane;
    for (int tok = gw; tok < SEQ; tok += NGW) { const int row = ROW0 + tok; f32x4 v[8];
#pragma unroll
        for (int j = 0; j < 8; ++j) v[j] = *(const f32x4*)(Y + (size_t)row * DM + 4 * lane + 256 * j);
        ln_core(v, g, b, lane);
        float lg[8];
#pragma unroll
        for (int e = 0; e < 8; ++e) lg[e] = 0.f;
        const LAS float* wl = wr_l + lane * 36;
#pragma unroll
        for (int j = 0; j < 8; ++j) {
#pragma unroll
            for (int i = 0; i < 4; ++i) { const f32x4 w0 = *(const LAS f32x4*)(wl + j * 2304 + i * 8), w1 = *(const LAS f32x4*)(wl + j * 2304 + i * 8 + 4); const float x = v[j][i];
                lg[0] += x * w0[0]; lg[1] += x * w0[1]; lg[2] += x * w0[2]; lg[3] += x * w0[3]; lg[4] += x * w1[0]; lg[5] += x * w1[1]; lg[6] += x * w1[2]; lg[7] += x * w1[3]; }
            __builtin_amdgcn_sched_barrier(0); }
#pragma unroll
        for (int e = 0; e < 8; ++e) lg[e] = wave_sum(lg[e]) + a.in[I_MBROUTER][e];
        int e0 = 0; float v0 = lg[0];
#pragma unroll
        for (int e = 1; e < 8; ++e) if (lg[e] > v0) { v0 = lg[e]; e0 = e; }
        int e1 = -1; float v1 = -__builtin_inff();
#pragma unroll
        for (int e = 0; e < 8; ++e) if (e != e0 && lg[e] > v1) { v1 = lg[e]; e1 = e; }
        const float g1 = 1.0f / (1.0f + expf(v0 - v1)), g0 = 1.0f - g1;
        int p0 = 0, p1 = 0;
        if (lane == 0) { p0 = (int)atomicAdd(F.ctl + CW_CNT + 64 * e0, 1u); p1 = (int)atomicAdd(F.ctl + CW_CNT + 64 * e1, 1u);
            rinfo[e0 * CAP + p0] = tok * 2; rinfo[e1 * CAP + p1] = tok * 2 + 1; tokg[tok * 2] = g0; tokg[tok * 2 + 1] = g1; tokep[tok * 2] = e0 * CAP + p0; tokep[tok * 2 + 1] = e1 * CAP + p1; }
        p0 = __shfl(p0, 0); p1 = __shfl(p1, 0);
        unsigned char* x0 = XG + ((size_t)e0 * CAP + p0) * DM; unsigned char* x1 = XG + ((size_t)e1 * CAP + p1) * DM;
#pragma unroll
        for (int j = 0; j < 8; ++j) { const unsigned pk = pack4_fp8_sc(v[j][0], v[j][1], v[j][2], v[j][3], 1.0f / SX8);
            *(unsigned*)(x0 + 4 * lane + 256 * j) = pk; *(unsigned*)(x1 + 4 * lane + 256 * j) = pk; } }
}
__device__ __forceinline__ void moe_tables(Frame& F, int nNx) {
    __syncthreads();
    if (F.tid == 0) { int pu = 0, seg = 0; int cnt[8];
#pragma unroll
        for (int e = 0; e < 8; ++e) cnt[e] = (int)__hip_atomic_load(F.ctl + CW_CNT + 64 * e, __ATOMIC_RELAXED, __HIP_MEMORY_SCOPE_AGENT);
#pragma unroll
        for (int e = 0; e < 8; ++e) { const int c = cnt[e]; const int nt = (c + 255) >> 8;
            F.MISC[e] = c; F.MISC[8 + e] = nt; F.MISC[16 + e] = pu; F.MISC[32 + e] = seg; pu += nt * nNx; seg += nt * 256; }
        F.MISC[24] = pu; }
    __syncthreads();
}
__device__ __forceinline__ void moe_tables_down(Frame& F) {
    __syncthreads();
    if (F.tid == 0) { int tp = 0, puA = 0, puB = 0, ovf = 0; int cnt[8];
#pragma unroll
        for (int e = 0; e < 8; ++e) cnt[e] = (int)__hip_atomic_load(F.ctl + CW_CNT + 64 * e, __ATOMIC_RELAXED, __HIP_MEMORY_SCOPE_AGENT);
#pragma unroll
        for (int e = 0; e < 8; ++e) { const int c = cnt[e]; const int nt = (c + 255) >> 8;
            int nA = FULL_TILES - tp; nA = nA < 0 ? 0 : (nA > nt ? nt : nA); const int nB = nt - nA;
            F.MISC[e] = c; F.MISC[8 + e] = nA; F.MISC[16 + e] = puA; F.MISC[32 + e] = tp * 256; F.MISC[40 + e] = 0; F.MISC[48 + e] = 0;
            F.MISC[128 + e] = c; F.MISC[136 + e] = nB; F.MISC[144 + e] = puB; F.MISC[160 + e] = tp * 256; F.MISC[168 + e] = nA; F.MISC[176 + e] = ovf;
            puA += nA * 8; puB += nB * 8 * KSB; ovf += nB; tp += nt; }
        F.MISC[24] = puA; F.MISC[152] = puB; }
    __syncthreads();
}
__device__ __forceinline__ void p16_final(Frame& F, const Args& a) {
    unsigned char* ws = F.ws; const float* Y = (const float*)(ws + WS_Y); const bf16_t* YM = (const bf16_t*)(ws + WS_M_XG); const bf16_t* YX = (const bf16_t*)(ws + WS_M_XG + 64 * MiB);
    const float* tokg = (const float*)(ws + WS_TOKG); const int* tokep = (const int*)(ws + WS_TOKG + 65536);
    const float* g = a.in[I_LNFG] + DM; const float* b = a.in[I_LNFB] + DM; const float* g3 = a.in[I_LNMG] + DM; const float* b3 = a.in[I_LNMB] + DM;
    const int gw = F.vcu * 8 + F.wave, NGW = F.G * 8;
    __syncthreads();
    if (F.tid == 0) { int tp = 0; int cnt[8];
#pragma unroll
        for (int e = 0; e < 8; ++e) cnt[e] = (int)__hip_atomic_load(F.ctl + CW_CNT + 64 * e, __ATOMIC_RELAXED, __HIP_MEMORY_SCOPE_AGENT);
#pragma unroll
        for (int e = 0; e < 8; ++e) { F.MISC[200 + e] = tp; tp += (cnt[e] + 255) >> 8; } }
    __syncthreads();
    const int lane0 = F.lane;
    for (int tok = gw; tok < SEQ; tok += NGW) { const int row = ROW0 + tok; f32x4 v[8]; const float g0 = tokg[tok * 2], g1 = tokg[tok * 2 + 1];
        int lane = lane0; asm volatile("" : "+v"(lane));
        int sr0 = -1, sr1 = -1;
        { const int ep = __builtin_amdgcn_readfirstlane(tokep[tok * 2]), e = ep >> 13, p = ep & (CAP - 1), gid = F.MISC[200 + e] + (p >> 8); if (gid >= FULL_TILES) sr0 = (gid - FULL_TILES) * 256 + (p & 255); }
        { const int ep = __builtin_amdgcn_readfirstlane(tokep[tok * 2 + 1]), e = ep >> 13, p = ep & (CAP - 1), gid = F.MISC[200 + e] + (p >> 8); if (gid >= FULL_TILES) sr1 = (gid - FULL_TILES) * 256 + (p & 255); }
        sr0 = __builtin_amdgcn_readfirstlane(sr0); sr1 = __builtin_amdgcn_readfirstlane(sr1);
#pragma unroll
        for (int j = 0; j < 8; ++j) v[j] = *(const f32x4*)(Y + (size_t)row * DM + 4 * lane + 256 * j);
        ln_core(v, g3, b3, lane);
#pragma unroll
        for (int j = 0; j < 8; ++j) { const int col = 4 * lane + 256 * j;
            f32x4 y0 = ld4bf(YM + ((size_t)0 * SEQ + tok) * DM + col), y1 = ld4bf(YM + ((size_t)1 * SEQ + tok) * DM + col);
            if (sr0 >= 0) {
#pragma unroll
                for (int q = 0; q < KSB - 1; ++q) y0 += ld4bf(YX + ((size_t)q * OVF_ROWS + sr0) * DM + col); }
            if (sr1 >= 0) {
#pragma unroll
                for (int q = 0; q < KSB - 1; ++q) y1 += ld4bf(YX + ((size_t)q * OVF_ROWS + sr1) * DM + col); }
            v[j] = v[j] * ALPHA + y0 * g0 + y1 * g1; if (j & 1) __builtin_amdgcn_sched_barrier(0); }
        ln_core(v, g, b, lane);
#pragma unroll
        for (int j = 0; j < 8; ++j) *(f32x4*)(a.out + (size_t)tok * DM + 4 * lane + 256 * j) = v[j]; }
}

__global__ void __launch_bounds__(512, 2) fwd(Args args) {
    extern __shared__ __attribute__((aligned(16))) unsigned char lds[];
    Frame F;
    F.lds = (LAS unsigned char*)lds; F.MISC = (volatile LAS int*)(F.lds + MISC_OFF);
    F.tid = threadIdx.x; F.lane = F.tid & 63; F.wave = __builtin_amdgcn_readfirstlane(F.tid >> 6);
    F.G = gridDim.x; { const int bx = blockIdx.x; F.vcu = (F.G % 8 == 0) ? (bx % 8) * (F.G / 8) + bx / 8 : bx; }
    F.ws = args.ws; F.ctl = (unsigned*)(args.ws + WS_CTL);
    unsigned char* ws = args.ws;
    for (int u = F.tid; u < 256; u += 512) F.MISC[u] = 0;
    __syncthreads();
#if MK_ONE_LAUNCH
    XcdBarrier bar = xcd_barrier_post(F.ctl + CW_BAR, (volatile LAS unsigned*)(F.MISC + 64));
#define GRID_BAR() xcd_barrier(bar)
#else
#define GRID_BAR() do { } while (0)
#endif
    const int lo = args.ph_lo, hi = args.ph_hi;
#define IN(k) (lo <= (k) && (k) < hi)
#define SEAM(k) do { if (IN(k) && IN((k) + 1)) GRID_BAR(); } while (0)
#define REP(k) _Pragma("unroll") for (int rep_ = 0; rep_ < ((((DUP_MASK) >> (k)) & 1u) ? 2 : 1); ++rep_)
    LAS unsigned char* ring = F.lds;
    const int bx = (int)blockIdx.x;

    if (IN(0)) REP(0) { p0_prologue(F, args); SEAM(0); }
    if (IN(1)) REP(1) {
        pg8::DenseSched<0> S{NPAN, NIN / 256, F.G, bx, 0, (const char*)(ws + WS_L_H0B), (const char*)(ws + WS_W_IN), (size_t)256 * DM * 2, (size_t)256 * DM * 2};
        pg8::EpiIn E{ws, args.in[I_FBIAS]};
        if (F.G != 256) calc_c12(F, (const bf16_t*)(ws + WS_W_PIN), DM, args.in[I_LNFG], args.in[I_LNFB], (float*)(ws + WS_C12), (float*)(ws + WS_C12) + DM, F.vcu * 8 + F.wave, F.G * 8);
        pg8::gemm_phase(ring, DM, DM, DM, S, E);
        if (F.G == 256 && bx >= 49) { calc_c12(F, (const bf16_t*)(ws + WS_W_PIN), DM, args.in[I_LNFG], args.in[I_LNFB], (float*)(ws + WS_C12), (float*)(ws + WS_C12) + DM, (bx - 49) * 8 + F.wave, 207 * 8);
            convert_range(F, args, I_A, I_B, (bx - 49) * 8 + F.wave, 207 * 8); }
        SEAM(1);
    }
    if (IN(2)) REP(2) {
        p2_ext(F);
        pg8::DenseSched<1> S{NPAN, NUP / 256, F.G, bx, 0, (const char*)(ws + WS_L_CQKV), (const char*)(ws + WS_W_UP), (size_t)256 * 1024 * 2, (size_t)256 * 512 * 2};
        pg8::EpiUp E{(const float*)(ws + WS_SSQ), (const float*)(ws + WS_CS), (bf16_t*)(ws + WS_L_QP), (bf16_t*)(ws + WS_L_KP), (bf16_t*)(ws + WS_L_VP)};
        pg8::gemm_phase(ring, 512, 1024, 512, S, E); SEAM(2);
    }
#if NAIVE_ATTN
    if (IN(3)) REP(3) { p3_attn_naive(F); SEAM(3); }
#else
    if (IN(3)) REP(3) { p3_attn(F, args); SEAM(3); }
#endif
    if (IN(4)) REP(4) {
        pg8::DenseSched<0> S{32, 8, F.G, bx, 1, (const char*)(ws + WS_L_O), (const char*)(ws + WS_W_OUT), (size_t)256 * DM * 2, (size_t)256 * DM * 2};
        pg8::EpiRes<0> E{(float*)(ws + WS_Y), nullptr, args.in[I_X], args.in[I_META], nullptr, nullptr};
        pg8::gemm_phase(ring, DM, DM, DM, S, E);
        skinny_meta<0>(F, (const bf16_t*)(ws + WS_L_O), DM, (const bf16_t*)(ws + WS_W_OUT), DM, (float*)(ws + WS_Y), args.in[I_META]); SEAM(4);
    }
    if (IN(5)) REP(5) { ln_phase(F, (const float*)(ws + WS_Y), args.in[I_LNMG], args.in[I_LNMB], (float*)(ws + WS_L_H1F), (bf16_t*)(ws + WS_L_H1B), true); SEAM(5); }
    if (IN(6)) REP(6) {
        pg8::DenseSched<0> S{NPAN, 2 * FFN / 256, F.G, bx, 0, (const char*)(ws + WS_L_H1B), (const char*)(ws + WS_W_GU), (size_t)256 * DM * 2, (size_t)256 * DM * 2};
        pg8::EpiGU E{(bf16_t*)(ws + WS_L_ACT), FFN};
        pg8::gemm_phase(ring, DM, DM, DM, S, E);
        if (F.G == 256 && bx >= 172) convert_range(F, args, I_B, I10, (bx - 172) * 8 + F.wave, 84 * 8);
        SEAM(6);
    }
    if (IN(7)) REP(7) {
        pg8::DenseSched<0> S{32, 8, F.G, bx, 1, (const char*)(ws + WS_L_ACT), (const char*)(ws + WS_W_DN), (size_t)256 * FFN * 2, (size_t)256 * FFN * 2};
        pg8::EpiResStat E{(float*)(ws + WS_Y), (const float*)(ws + WS_L_H1F), args.in[I_LNMG], args.in[I_LNMB], (bf16_t*)(ws + WS_L_H2B), (float*)(ws + WS_SLOT), F.lds};
        pg8::gemm_phase(ring, FFN, FFN, FFN, S, E);
        skinny_meta<1>(F, (const bf16_t*)(ws + WS_L_ACT), FFN, (const bf16_t*)(ws + WS_W_DN), FFN, (float*)(ws + WS_Y), (const float*)(ws + WS_L_H1F), args.in[I_LNMG], args.in[I_LNMB]); SEAM(7);
    }
    if (IN(9)) REP(9) {
        pg8::DenseSched<0> S{32, 8, F.G, bx, 1, (const char*)(ws + WS_L_H2B), (const char*)(ws + WS_W_PIN), (size_t)256 * DM * 2, (size_t)256 * DM * 2};
        pg8::EpiPoolIn E{(bf16_t*)(ws + WS_L_HP), (const float*)(ws + WS_SLOT), (const float*)(ws + WS_C12), (const float*)(ws + WS_C12) + DM, (float*)(ws + WS_L_H2F)};
        volatile LAS float* ms = (volatile LAS float*)(F.MISC + 208);
        meta_stats(F, (const float*)(ws + WS_Y), ms);
        pg8::gemm_phase(ring, DM, DM, DM, S, E);
        skinny_meta_ln(F, (const float*)(ws + WS_Y), ms, (const bf16_t*)(ws + WS_W_PIN), (const float*)(ws + WS_C12) + DM, (bf16_t*)(ws + WS_L_HP)); SEAM(9);
    }
    if (IN(10)) REP(10) { p10_pool(F); SEAM(10); }
    if (IN(11)) REP(11) {
        pg8::DenseSched<2> S{32, 8, F.G, bx, 1, (const char*)(ws + WS_L_PB), (const char*)(ws + WS_W_GRP), (size_t)256 * DM * 2, (size_t)256 * 512 * 2};
        pg8::EpiBf E{(bf16_t*)(ws + WS_L_YP)};
        pg8::gemm_phase(ring, 512, DM, 512, S, E); SEAM(11);
    }
    if (IN(12)) REP(12) {
        pg8::DenseSched<0> S{32, 8, F.G, bx, 1, (const char*)(ws + WS_L_YP), (const char*)(ws + WS_W_POUT), (size_t)256 * DM * 2, (size_t)256 * DM * 2};
        pg8::EpiRes<1> E{(float*)(ws + WS_Y), (const float*)(ws + WS_L_H2F), nullptr, nullptr, args.in[I_LNFG], args.in[I_LNFB]};
        pg8::gemm_phase(ring, DM, DM, DM, S, E); SEAM(12);
    }
    if (IN(13)) REP(13) { p13_ln_route(F, args); SEAM(13); }
    if (IN(14)) REP(14) {
        moe_tables(F, 2 * FE / 256);
        pg8::MoeSched<0> S{F.MISC, F.G, bx, 2 * FE / 256, (const char*)(ws + WS_M_XG), (const char*)(ws + WS_W_MGU), (size_t)DM, (size_t)2 * FE * DM, (size_t)256 * DM, 0};
        pg8::EpiGU8 E{ws + WS_M_ACT, F.MISC};
        pg8::gemm_phase<true>(ring, DM / 2, DM / 2, DM / 2, S, E); SEAM(14);
    }
    if (IN(15)) REP(15) {
        moe_tables_down(F);
        pg8::EpiMoeDown E{(bf16_t*)(ws + WS_M_XG), (bf16_t*)(ws + WS_M_XG + 64 * MiB), (const int*)(ws + WS_RINFO)};
        { pg8::MoeSched<1> S{F.MISC, F.G, bx, 8, (const char*)(ws + WS_M_ACT), (const char*)(ws + WS_W_MDN), (size_t)FE, (size_t)DM * FE, (size_t)256 * FE, 0};
          pg8::gemm_phase<true>(ring, FE / 2, FE / 2, FE / 2, S, E); }
        { pg8::MoeSched<1> S{F.MISC + 128, F.G, bx, 8 * KSB, (const char*)(ws + WS_M_ACT), (const char*)(ws + WS_W_MDN), (size_t)FE, (size_t)DM * FE, (size_t)256 * FE, (size_t)(FE / KSB)};
          pg8::gemm_phase<true>(ring, FE / KSB / 2, FE / 2, FE / 2, S, E); }
        SEAM(15);
    }
    if (IN(16)) REP(16) { p16_final(F, args); }
#undef IN
#undef SEAM
}

extern "C" void kernel_launch(void* const* d_in, const int* in_sizes, int n_in, void* d_out, int out_size, void* d_ws, size_t ws_size, hipStream_t stream) {
    static int grid = 0;
    if (grid == 0) {
        if (n_in != 25 || out_size != SEQ * DM || ws_size < WS_END) { fprintf(stderr, "kernel_launch: unexpected shapes (n_in %d, out %d, ws %zu < %zu)\n", n_in, out_size, ws_size, (size_t)WS_END); grid = -1; return; }
        int dev = 0, cus = 0, per_cu = 0;
        if (hipGetDevice(&dev) != hipSuccess || hipDeviceGetAttribute(&cus, hipDeviceAttributeMultiprocessorCount, dev) != hipSuccess) { grid = -1; return; }
        if (hipFuncSetAttribute((const void*)fwd, hipFuncAttributeMaxDynamicSharedMemorySize, LDS_BYTES) != hipSuccess) { fprintf(stderr, "kernel_launch: hipFuncSetAttribute failed\n"); grid = -1; return; }
        if (hipOccupancyMaxActiveBlocksPerMultiprocessor(&per_cu, (const void*)fwd, 512, LDS_BYTES) != hipSuccess || per_cu < 1) fprintf(stderr, "kernel_launch: occupancy query reports %d\n", per_cu);
        (void)hipGetLastError();
        grid = cus;
    }
    if (grid < 0) return;
    (void)hipMemsetAsync((char*)d_ws + WS_CTL, 0, CTL_ZERO_BYTES, stream);
    Args a{};
    for (int i = 0; i < 25; ++i) a.in[i] = (const float*)d_in[i];
    a.out = (float*)d_out; a.ws = (unsigned char*)d_ws;
#if MK_ONE_LAUNCH
    a.ph_lo = 0; a.ph_hi = NPHASE;
    hipLaunchKernelGGL(fwd, dim3(grid), dim3(512), LDS_BYTES, stream, a);
#else
    for (int p = 0; p < NPHASE; ++p) { a.ph_lo = p; a.ph_hi = p + 1; hipLaunchKernelGGL(fwd, dim3(grid), dim3(512), LDS_BYTES, stream, a); }
#endif
}
```
